# Optimizing an MI355X kernel written in HIP

```python
import jax
import jax.numpy as jnp
from jax import lax
import numpy as np

D_MODEL = 1024
BATCH = 4
SEQ = 4096
DEPTH = 2

HEAD_DIM = 64
A_HEADS = 4
A_KV_HEADS = 2
A_GROUP = A_HEADS // A_KV_HEADS
A_WINDOW = 128
B_HEADS = 4
B_Q_RANK = 256
B_KV_RANK = 128
B_NOPE = 64
B_ROPE = 32
B_V = HEAD_DIM
ROPE_THETA = 10000.0
C_HEADS = 8
C_KV_HEADS = 2
C_GROUP = C_HEADS // C_KV_HEADS
C_CMP_BLOCK = 32
C_CMP_STRIDE = 16
C_CMP_HIDDEN = 128
C_SEL_BLOCK = 64
C_SEL_TOP = 16
C_WINDOW = 512
Q_BLOCK = 128
SEL_Q_BLOCK = 64
D_FF = 4096
N_EXPERTS = 8
TOP_K = 2
D_FF_EXPERT = 3584
NORM_EPS = 1e-6
NEG_INF = -1e30

A_Q_COLS = A_HEADS * HEAD_DIM
A_KV_COLS = A_KV_HEADS * HEAD_DIM
C_Q_COLS = C_HEADS * HEAD_DIM
C_KV_COLS = C_KV_HEADS * HEAD_DIM
C_GATE_COLS = C_HEADS * 3
IN_SPLITS = (A_Q_COLS, A_KV_COLS, A_KV_COLS, B_Q_RANK, B_KV_RANK, B_ROPE, C_Q_COLS,
             C_KV_COLS, C_KV_COLS, C_KV_COLS, C_KV_COLS, C_KV_COLS, C_KV_COLS, C_GATE_COLS)
N_IN = sum(IN_SPLITS)
MIX_WIDTH = A_HEADS * HEAD_DIM + B_HEADS * B_V + C_HEADS * HEAD_DIM

kernel_name = 'hybrid_swa_mla_nsa_moe_block'


def _rmsnorm(x, g):
    xf = x.astype(jnp.float32)
    y = xf * lax.rsqrt(jnp.mean(xf * xf, axis=-1, keepdims=True) + NORM_EPS)
    return (y * g.astype(jnp.float32)).astype(x.dtype)


def _alibi_slopes(n):
    return np.array([2.0 ** (-8.0 * (i + 1) / n) for i in range(n)], dtype=np.float32)


def _rope(x, pos):
    d = x.shape[-1]
    inv = (ROPE_THETA ** (-np.arange(0, d, 2, dtype=np.float32) / d)).astype(np.float32)
    ang = pos.astype(jnp.float32)[..., None] * inv
    cos = jnp.cos(ang)[:, :, None, :]
    sin = jnp.sin(ang)[:, :, None, :]
    xf = x.astype(jnp.float32)
    x1, x2 = xf[..., : d // 2], xf[..., d // 2:]
    return jnp.concatenate([x1 * cos - x2 * sin, x2 * cos + x1 * sin], axis=-1).astype(x.dtype)


def _banded_attention(q, k, v, window, slopes, sinks=None):
    B, S, G, R, dh = q.shape
    nb = S // Q_BLOCK
    span = Q_BLOCK + window
    kp = jnp.pad(k, ((0, 0), (window, 0), (0, 0), (0, 0)))
    vp = jnp.pad(v, ((0, 0), (window, 0), (0, 0), (0, 0)))
    idx = np.arange(nb)[:, None] * Q_BLOCK + np.arange(span)[None, :]
    kb = kp[:, idx]
    vb = vp[:, idx]
    qb = q.reshape(B, nb, Q_BLOCK, G, R, dh)
    s = jnp.einsum('bnqgrd,bnkgd->bngrqk', qb, kb).astype(jnp.float32) * (dh ** -0.5)
    dist = (np.arange(Q_BLOCK)[:, None] + window) - np.arange(span)[None, :]
    kabs = idx - window
    valid = (dist[None] >= 0) & (dist[None] < window) & (kabs[:, None, :] >= 0)
    s = s - slopes[None, None, :, :, None, None] * dist.astype(np.float32)
    s = jnp.where(valid[None, :, None, None], s, NEG_INF)
    if sinks is None:
        p = jax.nn.softmax(s, axis=-1)
    else:
        sk = sinks.astype(jnp.float32)[None, None, :, :, None, None]
        m = jnp.maximum(jnp.max(s, axis=-1, keepdims=True), sk)
        e = jnp.exp(s - m)
        p = e / (jnp.sum(e, axis=-1, keepdims=True) + jnp.exp(sk - m))
    o = jnp.einsum('bngrqk,bnkgd->bnqgrd', p.astype(v.dtype), vb)
    return o.reshape(B, S, G, R, dh)


def _causal_attention_blocks(q, k, v):
    B, S, H, dqk = q.shape
    dv = v.shape[-1]
    nb = S // Q_BLOCK
    scale = dqk ** -0.5
    qb = jnp.moveaxis(q.reshape(B, nb, Q_BLOCK, H, dqk), 1, 0)
    kpos = jnp.arange(S)

    def block(args):
        qi, start = args
        s = jnp.einsum('bqhd,bkhd->bhqk', qi, k).astype(jnp.float32) * scale
        qpos = start + jnp.arange(Q_BLOCK)
        s = jnp.where(kpos[None, :] <= qpos[:, None], s, NEG_INF)
        p = jax.nn.softmax(s, axis=-1).astype(v.dtype)
        return jnp.einsum('bhqk,bkhd->bqhd', p, v)

    o = lax.map(block, (qb, jnp.arange(nb) * Q_BLOCK))
    return jnp.moveaxis(o, 0, 1).reshape(B, S, H, dv)


def _nsa_attention(q, k_cmp, v_cmp, k_sel, v_sel, k_win, v_win, gates,
                   w1k, w2k, pek, w1v, w2v, pev, slopes):
    B, S, G, R, dh = q.shape
    scale = dh ** -0.5
    n_cmp = (S - C_CMP_BLOCK) // C_CMP_STRIDE + 1
    n_sel = S // C_SEL_BLOCK
    n_top = min(C_SEL_TOP, n_sel)
    t = np.arange(S)

    cstart = np.arange(n_cmp) * C_CMP_STRIDE
    cend = cstart + C_CMP_BLOCK - 1
    cidx = cstart[:, None] + np.arange(C_CMP_BLOCK)[None, :]

    def compress(xs, w1, w2, pe):
        blocks = xs[:, cidx] + pe[None, None, :, None, :]
        hid = jax.nn.gelu(jnp.einsum('bnlgd,lde->bnge', blocks, w1))
        return jnp.einsum('bnge,ed->bngd', hid, w2)

    kc = compress(k_cmp, w1k, w2k, pek)
    vc = compress(v_cmp, w1v, w2v, pev)
    cdist = (t[:, None] - cend[None, :]).astype(np.float32)
    cvalid = cdist >= 0
    s = jnp.einsum('bsgrd,bngd->bgrsn', q, kc).astype(jnp.float32) * scale
    s = s - slopes[None, :, :, None, None] * cdist
    s = jnp.where(cvalid, s, NEG_INF)
    has_cmp = (t >= C_CMP_BLOCK - 1).astype(np.float32)[:, None]
    p_cmp = jax.nn.softmax(s, axis=-1) * has_cmp
    o_cmp = jnp.einsum('bgrsn,bngd->bsgrd', p_cmp.astype(vc.dtype), vc)

    sstart = np.arange(n_sel) * C_SEL_BLOCK
    send = sstart + C_SEL_BLOCK - 1
    overlap = np.clip(np.minimum(cend[:, None], send[None, :]) - np.maximum(cstart[:, None], sstart[None, :]) + 1,
                      0, None).astype(np.float32) / C_CMP_STRIDE
    imp = jnp.einsum('bgrsn,nj->bgsj', p_cmp, overlap)
    cur = t // C_SEL_BLOCK
    jj = np.arange(n_sel)
    avail = sstart[None, :] <= t[:, None]
    forced = (jj[None, :] == 0) | (jj[None, :] == cur[:, None]) | (jj[None, :] == cur[:, None] - 1)
    imp = jnp.where(avail, imp, NEG_INF)
    imp = jnp.where(forced, -NEG_INF, imp)
    _, sel_idx = lax.top_k(imp, n_top)

    ksb = jnp.moveaxis(k_sel.reshape(B, n_sel, C_SEL_BLOCK, G, dh), 3, 1)
    vsb = jnp.moveaxis(v_sel.reshape(B, n_sel, C_SEL_BLOCK, G, dh), 3, 1)
    nc = S // SEL_Q_BLOCK
    q_ch = jnp.moveaxis(q.reshape(B, nc, SEL_Q_BLOCK, G, R, dh), 1, 0)
    i_ch = jnp.moveaxis(sel_idx.reshape(B, G, nc, SEL_Q_BLOCK, n_top), 2, 0)
    bi = jnp.arange(B)[:, None, None, None]
    gi = jnp.arange(G)[None, :, None, None]
    n_keys = n_top * C_SEL_BLOCK

    def sel_block(args):
        qi, ii, start = args
        kg = ksb[bi, gi, ii].reshape(B, G, SEL_Q_BLOCK, n_keys, dh)
        vg = vsb[bi, gi, ii].reshape(B, G, SEL_Q_BLOCK, n_keys, dh)
        tq = start + jnp.arange(SEL_Q_BLOCK)
        kpos = (ii[..., None] * C_SEL_BLOCK + jnp.arange(C_SEL_BLOCK)).reshape(B, G, SEL_Q_BLOCK, n_keys)
        dist = (tq[None, None, :, None] - kpos).astype(jnp.float32)[:, :, None]
        sc = jnp.einsum('bqgrd,bgqkd->bgrqk', qi, kg).astype(jnp.float32) * scale
        sc = sc - slopes[None, :, :, None, None] * dist
        sc = jnp.where(dist >= 0, sc, NEG_INF)
        p = jax.nn.softmax(sc, axis=-1).astype(vg.dtype)
        return jnp.einsum('bgrqk,bgqkd->bqgrd', p, vg)

    o_slc = lax.map(sel_block, (q_ch, i_ch, jnp.arange(nc) * SEL_Q_BLOCK))
    o_slc = jnp.moveaxis(o_slc, 0, 1).reshape(B, S, G, R, dh)

    o_win = _banded_attention(q, k_win, v_win, C_WINDOW, slopes)

    return gates[..., 0:1] * o_cmp + gates[..., 1:2] * o_slc + gates[..., 2:3] * o_win


def _hybrid_mixer(h, positions, w_in, a_sinks, g_cq, w_uq, g_ckv, w_ukv,
                  c_w1_k, c_w2_k, c_pe_k, c_w1_v, c_w2_v, c_pe_v, g_oa, g_ob, g_oc, w_o):
    B, S, _ = h.shape
    proj = jnp.einsum('bsd,dn->bsn', h, w_in)
    cuts = np.cumsum(IN_SPLITS)[:-1].tolist()
    (a_q, a_k, a_v, b_cq, b_ckv, b_kr, c_q,
     c_kc, c_vc, c_ks, c_vs, c_kw, c_vw, c_g) = jnp.split(proj, cuts, axis=-1)

    qa = a_q.reshape(B, S, A_KV_HEADS, A_GROUP, HEAD_DIM)
    ka = a_k.reshape(B, S, A_KV_HEADS, HEAD_DIM)
    va = a_v.reshape(B, S, A_KV_HEADS, HEAD_DIM)
    a_slopes = jnp.asarray(_alibi_slopes(A_HEADS).reshape(A_KV_HEADS, A_GROUP))
    o_a = _banded_attention(qa, ka, va, A_WINDOW, a_slopes,
                            a_sinks.reshape(A_KV_HEADS, A_GROUP)).reshape(B, S, A_HEADS * HEAD_DIM)

    q_b = jnp.einsum('bsr,rn->bsn', _rmsnorm(b_cq, g_cq), w_uq).reshape(B, S, B_HEADS, B_NOPE + B_ROPE)
    q_b = jnp.concatenate([q_b[..., :B_NOPE], _rope(q_b[..., B_NOPE:], positions)], axis=-1)
    kv_b = jnp.einsum('bsr,rn->bsn', _rmsnorm(b_ckv, g_ckv), w_ukv).reshape(B, S, B_HEADS, B_NOPE + B_V)
    k_rope = jnp.broadcast_to(_rope(b_kr[:, :, None, :], positions), (B, S, B_HEADS, B_ROPE))
    k_b = jnp.concatenate([kv_b[..., :B_NOPE], k_rope], axis=-1)
    o_b = _causal_attention_blocks(q_b, k_b, kv_b[..., B_NOPE:]).reshape(B, S, B_HEADS * B_V)

    kv_shape = (B, S, C_KV_HEADS, HEAD_DIM)
    gates = jax.nn.sigmoid(c_g.astype(jnp.float32)).astype(h.dtype).reshape(B, S, C_KV_HEADS, C_GROUP, 3)
    c_slopes = jnp.asarray(_alibi_slopes(C_HEADS).reshape(C_KV_HEADS, C_GROUP))
    o_c = _nsa_attention(c_q.reshape(B, S, C_KV_HEADS, C_GROUP, HEAD_DIM),
                         c_kc.reshape(kv_shape), c_vc.reshape(kv_shape),
                         c_ks.reshape(kv_shape), c_vs.reshape(kv_shape),
                         c_kw.reshape(kv_shape), c_vw.reshape(kv_shape), gates,
                         c_w1_k, c_w2_k, c_pe_k, c_w1_v, c_w2_v, c_pe_v, c_slopes).reshape(B, S, C_HEADS * HEAD_DIM)

    mixed = jnp.concatenate([_rmsnorm(o_a, g_oa), _rmsnorm(o_b, g_ob), _rmsnorm(o_c, g_oc)], axis=-1)
    return jnp.einsum('bsm,md->bsd', mixed, w_o)


def _swiglu(h, wg, wu, wd):
    a = jnp.einsum('bsd,df->bsf', h, wg)
    b = jnp.einsum('bsd,df->bsf', h, wu)
    return jnp.einsum('bsf,fd->bsd', jax.nn.silu(a) * b, wd)


def _moe(h, w_router, w_gate, w_up, w_down):
    logits = jnp.einsum('bsd,de->bse', h, w_router).astype(jnp.float32)
    top_v, top_i = lax.top_k(logits, TOP_K)
    top_w = jax.nn.softmax(top_v, axis=-1)
    combine = jnp.sum(jax.nn.one_hot(top_i, N_EXPERTS, dtype=jnp.float32) * top_w[..., None], axis=-2)
    combine = combine.astype(h.dtype)
    y = jnp.zeros_like(h)
    for e in range(N_EXPERTS):
        y = y + combine[..., e:e + 1] * _swiglu(h, w_gate[e], w_up[e], w_down[e])
    return y


def setup_inputs(seed: int = 0) -> dict:
    key = jax.random.key(seed)
    ks = jax.random.split(key, 32)
    n_dense = (DEPTH + 1) // 2
    n_moe = DEPTH // 2
    f32 = jnp.float32

    def nrm(k, shape, scale):
        return jax.random.normal(k, shape, f32) * scale

    def gain(k, shape):
        return 1.0 + 0.1 * jax.random.normal(k, shape, f32)

    x = jax.random.normal(ks[0], (BATCH, SEQ, D_MODEL), f32)
    offset = jax.random.randint(ks[1], (BATCH, 1), 0, 1024, dtype=jnp.int32)
    positions = (offset + jnp.arange(SEQ, dtype=jnp.int32)[None, :]).astype(jnp.int32)
    return {
        'x': x,
        'positions': positions,
        'w_in': nrm(ks[2], (DEPTH, D_MODEL, N_IN), D_MODEL ** -0.5),
        'a_sinks': nrm(ks[3], (DEPTH, A_HEADS), 0.5),
        'g_cq': gain(ks[4], (DEPTH, B_Q_RANK)),
        'w_uq': nrm(ks[5], (DEPTH, B_Q_RANK, B_HEADS * (B_NOPE + B_ROPE)), B_Q_RANK ** -0.5),
        'g_ckv': gain(ks[6], (DEPTH, B_KV_RANK)),
        'w_ukv': nrm(ks[7], (DEPTH, B_KV_RANK, B_HEADS * (B_NOPE + B_V)), B_KV_RANK ** -0.5),
        'c_w1_k': nrm(ks[8], (DEPTH, C_CMP_BLOCK, HEAD_DIM, C_CMP_HIDDEN), (C_CMP_BLOCK * HEAD_DIM) ** -0.5),
        'c_w2_k': nrm(ks[9], (DEPTH, C_CMP_HIDDEN, HEAD_DIM), C_CMP_HIDDEN ** -0.5),
        'c_pe_k': nrm(ks[10], (DEPTH, C_CMP_BLOCK, HEAD_DIM), 0.1),
        'c_w1_v': nrm(ks[11], (DEPTH, C_CMP_BLOCK, HEAD_DIM, C_CMP_HIDDEN), (C_CMP_BLOCK * HEAD_DIM) ** -0.5),
        'c_w2_v': nrm(ks[12], (DEPTH, C_CMP_HIDDEN, HEAD_DIM), C_CMP_HIDDEN ** -0.5),
        'c_pe_v': nrm(ks[13], (DEPTH, C_CMP_BLOCK, HEAD_DIM), 0.1),
        'g_oa': gain(ks[14], (DEPTH, A_HEADS * HEAD_DIM)),
        'g_ob': gain(ks[15], (DEPTH, B_HEADS * B_V)),
        'g_oc': gain(ks[16], (DEPTH, C_HEADS * HEAD_DIM)),
        'w_o': nrm(ks[17], (DEPTH, MIX_WIDTH, D_MODEL), MIX_WIDTH ** -0.5),
        'g_pre_mix': gain(ks[18], (DEPTH, D_MODEL)),
        'g_post_mix': gain(ks[19], (DEPTH, D_MODEL)),
        'g_pre_ffn': gain(ks[20], (DEPTH, D_MODEL)),
        'g_post_ffn': gain(ks[21], (DEPTH, D_MODEL)),
        'ffn_w_gate': nrm(ks[22], (n_dense, D_MODEL, D_FF), D_MODEL ** -0.5),
        'ffn_w_up': nrm(ks[23], (n_dense, D_MODEL, D_FF), D_MODEL ** -0.5),
        'ffn_w_down': nrm(ks[24], (n_dense, D_FF, D_MODEL), D_FF ** -0.5),
        'moe_router': nrm(ks[25], (n_moe, D_MODEL, N_EXPERTS), D_MODEL ** -0.5),
        'moe_w_gate': nrm(ks[26], (n_moe, N_EXPERTS, D_MODEL, D_FF_EXPERT), D_MODEL ** -0.5),
        'moe_w_up': nrm(ks[27], (n_moe, N_EXPERTS, D_MODEL, D_FF_EXPERT), D_MODEL ** -0.5),
        'moe_w_down': nrm(ks[28], (n_moe, N_EXPERTS, D_FF_EXPERT, D_MODEL), D_FF_EXPERT ** -0.5),
    }


def reference(x, positions, w_in, a_sinks, g_cq, w_uq, g_ckv, w_ukv, c_w1_k, c_w2_k, c_pe_k,
              c_w1_v, c_w2_v, c_pe_v, g_oa, g_ob, g_oc, w_o, g_pre_mix, g_post_mix, g_pre_ffn,
              g_post_ffn, ffn_w_gate, ffn_w_up, ffn_w_down, moe_router, moe_w_gate, moe_w_up,
              moe_w_down):
    for l in range(DEPTH):
        h = _rmsnorm(x, g_pre_mix[l])
        m = _hybrid_mixer(h, positions, w_in[l], a_sinks[l], g_cq[l], w_uq[l], g_ckv[l], w_ukv[l],
                          c_w1_k[l], c_w2_k[l], c_pe_k[l], c_w1_v[l], c_w2_v[l], c_pe_v[l],
                          g_oa[l], g_ob[l], g_oc[l], w_o[l])
        x = x + _rmsnorm(m, g_post_mix[l])
        h = _rmsnorm(x, g_pre_ffn[l])
        if l % 2 == 0:
            f = _swiglu(h, ffn_w_gate[l // 2], ffn_w_up[l // 2], ffn_w_down[l // 2])
        else:
            f = _moe(h, moe_router[l // 2], moe_w_gate[l // 2], moe_w_up[l // 2], moe_w_down[l // 2])
        x = x + _rmsnorm(f, g_post_ffn[l])
    return x
```

```cpp
#include <hip/hip_runtime.h>
#include <stdint.h>
#include <math.h>

#define DI __device__ __forceinline__
constexpr int DM = 1024, NB = 4, SQ = 4096, NT = NB * SQ, NIN = 2232;
constexpr int O_AQ = 0, O_AK = 256, O_AV = 384, O_BCQ = 512, O_BCKV = 768, O_BKR = 896, O_CQ = 928, O_CKC = 1440, O_CVC = 1568,
              O_CKS = 1696, O_CVS = 1824, O_CKW = 1952, O_CVW = 2080, O_CG = 2208;
constexpr int NCMP = 255, DFF = 4096, NEXP = 8, DFE = 3584;
constexpr float EPS = 1e-6f;

DI float wave_sum(float v) { for (int o = 32; o > 0; o >>= 1) v += __shfl_xor(v, o); return v; }
DI float wave_max(float v) { for (int o = 32; o > 0; o >>= 1) v = fmaxf(v, __shfl_xor(v, o)); return v; }

__global__ __launch_bounds__(256) void k_rmsnorm(const float* __restrict__ x, const float* __restrict__ g, float* __restrict__ out) {
    const int row = blockIdx.x * 4 + (threadIdx.x >> 6), lane = threadIdx.x & 63;
    const float4* xr = (const float4*)(x + (size_t)row * DM); float4 v[4]; float s = 0.f;
#pragma unroll
    for (int j = 0; j < 4; ++j) { v[j] = xr[lane + 64 * j]; s += v[j].x * v[j].x + v[j].y * v[j].y + v[j].z * v[j].z + v[j].w * v[j].w; }
    s = wave_sum(s); const float r = 1.0f / sqrtf(s * (1.0f / DM) + EPS);
    float4* o = (float4*)(out + (size_t)row * DM);
#pragma unroll
    for (int j = 0; j < 4; ++j) { const float4 gg = ((const float4*)g)[lane + 64 * j]; o[lane + 64 * j] = make_float4(v[j].x * r * gg.x, v[j].y * r * gg.y, v[j].z * r * gg.z, v[j].w * r * gg.w); }
}
__global__ __launch_bounds__(256) void k_resnorm(const float* xin, const float* __restrict__ m, const float* __restrict__ g, float* xout) {
    const int row = blockIdx.x * 4 + (threadIdx.x >> 6), lane = threadIdx.x & 63;
    const float4* mr = (const float4*)(m + (size_t)row * DM); float4 v[4]; float s = 0.f;
#pragma unroll
    for (int j = 0; j < 4; ++j) { v[j] = mr[lane + 64 * j]; s += v[j].x * v[j].x + v[j].y * v[j].y + v[j].z * v[j].z + v[j].w * v[j].w; }
    s = wave_sum(s); const float r = 1.0f / sqrtf(s * (1.0f / DM) + EPS);
    const float4* xi = (const float4*)(xin + (size_t)row * DM); float4* o = (float4*)(xout + (size_t)row * DM);
#pragma unroll
    for (int j = 0; j < 4; ++j) { const float4 gg = ((const float4*)g)[lane + 64 * j]; const float4 xx = xi[lane + 64 * j];
        o[lane + 64 * j] = make_float4(xx.x + v[j].x * r * gg.x, xx.y + v[j].y * r * gg.y, xx.z + v[j].z * r * gg.z, xx.w + v[j].w * r * gg.w); }
}

template <bool DUAL, int EPI>
__global__ __launch_bounds__(256) void k_sgemm(const float* __restrict__ A, int lda, const int* __restrict__ aidx, const float* __restrict__ B, const float* __restrict__ B2, int ldb,
                                               float* __restrict__ C, int ldc, int M, const int* __restrict__ Mdev, int N, int K, const int* __restrict__ oidx, const float* __restrict__ oscale) {
    if (Mdev) M = *Mdev;
    const int m0 = blockIdx.y * 64, n0 = blockIdx.x * 64;
    if (m0 >= M) return;
    __shared__ float As[16][68]; __shared__ float Bs[16][64]; __shared__ float Bs2[DUAL ? 16 : 1][64];
    const int tid = threadIdx.x, tx = tid & 15, ty = tid >> 4;
    const int arow = tid >> 2, ak = (tid & 3) * 4, bk = tid >> 4, bn = (tid & 15) * 4;
    long aoff = -1; { const int gr = m0 + arow; if (gr < M) { const int r = aidx ? aidx[gr] : gr; if (r >= 0) aoff = (long)r * lda; } }
    const bool bfull = (n0 + bn + 3 < N);
    float acc[4][4], acc2[4][4];
#pragma unroll
    for (int i = 0; i < 4; ++i)
#pragma unroll
        for (int j = 0; j < 4; ++j) { acc[i][j] = 0.f; acc2[i][j] = 0.f; }
    for (int k0 = 0; k0 < K; k0 += 16) {
        float4 av = make_float4(0.f, 0.f, 0.f, 0.f); if (aoff >= 0) av = *(const float4*)(A + aoff + k0 + ak);
        As[ak + 0][arow] = av.x; As[ak + 1][arow] = av.y; As[ak + 2][arow] = av.z; As[ak + 3][arow] = av.w;
        float4 bv = make_float4(0.f, 0.f, 0.f, 0.f), bv2 = make_float4(0.f, 0.f, 0.f, 0.f);
        const size_t boff = (size_t)(k0 + bk) * ldb + n0 + bn;
        if (bfull) { bv = *(const float4*)(B + boff); if (DUAL) bv2 = *(const float4*)(B2 + boff); }
        else { if (n0 + bn < N) { bv.x = B[boff]; if (DUAL) bv2.x = B2[boff]; } if (n0 + bn + 1 < N) { bv.y = B[boff + 1]; if (DUAL) bv2.y = B2[boff + 1]; }
               if (n0 + bn + 2 < N) { bv.z = B[boff + 2]; if (DUAL) bv2.z = B2[boff + 2]; } }
        *(float4*)&Bs[bk][bn] = bv; if (DUAL) *(float4*)&Bs2[bk][bn] = bv2;
        __syncthreads();
#pragma unroll
        for (int kk = 0; kk < 16; ++kk) {
            const float4 a4 = *(const float4*)&As[kk][ty * 4]; const float4 b4 = *(const float4*)&Bs[kk][tx * 4];
            const float a[4] = {a4.x, a4.y, a4.z, a4.w}; const float b[4] = {b4.x, b4.y, b4.z, b4.w};
#pragma unroll
            for (int i = 0; i < 4; ++i)
#pragma unroll
                for (int j = 0; j < 4; ++j) acc[i][j] += a[i] * b[j];
            if (DUAL) { const float4 c4 = *(const float4*)&Bs2[kk][tx * 4]; const float c[4] = {c4.x, c4.y, c4.z, c4.w};
#pragma unroll
                for (int i = 0; i < 4; ++i)
#pragma unroll
                    for (int j = 0; j < 4; ++j) acc2[i][j] += a[i] * c[j]; }
        }
        __syncthreads();
    }
#pragma unroll
    for (int i = 0; i < 4; ++i) {
        const int row = m0 + ty * 4 + i; if (row >= M) continue;
        int orow = row; float sc = 1.f;
        if (EPI == 1) { orow = oidx[row]; sc = oscale[row]; if (orow < 0) continue; }
#pragma unroll
        for (int j = 0; j < 4; ++j) { const int col = n0 + tx * 4 + j; if (col >= N) continue;
            float v = acc[i][j]; if (DUAL) { const float a = v; v = a / (1.0f + expf(-a)) * acc2[i][j]; }
            if (EPI == 1) atomicAdd(C + (size_t)orow * ldc + col, v * sc); else C[(size_t)orow * ldc + col] = v; }
    }
}

DI float rope_inv(int i) { return exp2f(-(float)i * 0.83048202372184059f); }
__global__ __launch_bounds__(256) void k_mla_prep(const float* __restrict__ proj, const int* __restrict__ pos, const float* __restrict__ g_cq, const float* __restrict__ g_ckv,
                                                  float* __restrict__ cqn, float* __restrict__ ckvn, float* __restrict__ kr) {
    const int t = blockIdx.x * 4 + (threadIdx.x >> 6), lane = threadIdx.x & 63; const float* p = proj + (size_t)t * NIN;
    { const float4 v = *(const float4*)(p + O_BCQ + lane * 4); const float s = wave_sum(v.x * v.x + v.y * v.y + v.z * v.z + v.w * v.w); const float r = 1.0f / sqrtf(s * (1.0f / 256) + EPS);
      const float4 g = *(const float4*)(g_cq + lane * 4); *(float4*)(cqn + (size_t)t * 256 + lane * 4) = make_float4(v.x * r * g.x, v.y * r * g.y, v.z * r * g.z, v.w * r * g.w); }
    { const float2 v = *(const float2*)(p + O_BCKV + lane * 2); const float s = wave_sum(v.x * v.x + v.y * v.y); const float r = 1.0f / sqrtf(s * (1.0f / 128) + EPS);
      const float2 g = *(const float2*)(g_ckv + lane * 2); *(float2*)(ckvn + (size_t)t * 128 + lane * 2) = make_float2(v.x * r * g.x, v.y * r * g.y); }
    if (lane < 16) { const float ang = (float)pos[t] * rope_inv(lane); const float c = cosf(ang), s = sinf(ang); const float x1 = p[O_BKR + lane], x2 = p[O_BKR + 16 + lane];
        kr[(size_t)t * 32 + lane] = x1 * c - x2 * s; kr[(size_t)t * 32 + 16 + lane] = x2 * c + x1 * s; }
}
__global__ __launch_bounds__(256) void k_rope_q(float* __restrict__ qb, const int* __restrict__ pos) {
    const int gid = blockIdx.x * 256 + threadIdx.x; const int i = gid & 15, h = (gid >> 4) & 3, t = gid >> 6;
    float* q = qb + (size_t)t * 384 + h * 96 + 64; const float ang = (float)pos[t] * rope_inv(i); const float c = cosf(ang), s = sinf(ang);
    const float x1 = q[i], x2 = q[16 + i]; q[i] = x1 * c - x2 * s; q[16 + i] = x2 * c + x1 * s;
}

__global__ __launch_bounds__(128) void k_compress(const float* __restrict__ proj, const float* __restrict__ w1k, const float* __restrict__ w2k, const float* __restrict__ pek,
                                                  const float* __restrict__ w1v, const float* __restrict__ w2v, const float* __restrict__ pev, float* __restrict__ kc, float* __restrict__ vc) {
    __shared__ float blk[32 * 64]; __shared__ float hid[128];
    const int which = blockIdx.x & 1, g = (blockIdx.x >> 1) & 1, bn = blockIdx.x >> 2, n = bn % NCMP, b = bn / NCMP;
    const float* w1 = which ? w1v : w1k; const float* w2 = which ? w2v : w2k; const float* pe = which ? pev : pek; float* out = which ? vc : kc;
    const int coff = (which ? O_CVC : O_CKC) + g * 64; const int tid = threadIdx.x;
    for (int e = tid; e < 2048; e += 128) { const int l = e >> 6, d = e & 63; blk[e] = proj[(size_t)(b * SQ + 16 * n + l) * NIN + coff + d] + pe[e]; }
    __syncthreads();
    float a = 0.f;
    for (int k = 0; k < 2048; ++k) a += blk[k] * w1[(size_t)k * 128 + tid];
    { const float x = a; const float u = 0.7978845608028654f * (x + 0.044715f * x * x * x); hid[tid] = 0.5f * x * (1.0f + tanhf(u)); }
    __syncthreads();
    if (tid < 64) { float o = 0.f; for (int e = 0; e < 128; ++e) o += hid[e] * w2[e * 64 + tid]; out[((size_t)(b * NCMP + n) * 2 + g) * 64 + tid] = o; }
}

struct AttnArgs {
    const float* q; int qs, qoff;
    const float* k1; int k1s, k1off, k1h;
    const float* k2; int k2s;
    const float* v; int vs, voff, vh;
    float* o; int os;
    const float* sinks; const unsigned long long* selmask;
    int R, window; float scale, slope_step;
};
template <int MODE  , int DQK>
__global__ __launch_bounds__(64) void k_attn_naive(AttnArgs a) {
    const int lane = threadIdx.x, tmin = blockIdx.x * 64, t = tmin + lane, tmax = tmin + 63, hq = blockIdx.y, b = blockIdx.z, kvh = hq / a.R;
    float q[DQK], o[64];
    { const float* qp = a.q + (size_t)(b * SQ + t) * a.qs + a.qoff + hq * DQK;
#pragma unroll
      for (int d = 0; d < DQK; ++d) q[d] = qp[d]; }
#pragma unroll
    for (int d = 0; d < 64; ++d) o[d] = 0.f;
    const float slope = a.slope_step > 0.f ? exp2f(-a.slope_step * (float)(hq + 1)) : 0.f;
    float m = -1e30f, l = 0.f;
    if (a.sinks) { m = a.sinks[hq]; l = 1.f; }
    const float* k1b = a.k1 + (size_t)b * SQ * a.k1s + a.k1off + kvh * a.k1h; const float* k2b = (DQK > 64) ? a.k2 + (size_t)b * SQ * a.k2s : nullptr;
    const float* vb = a.v + (size_t)b * SQ * a.vs + a.voff + kvh * a.vh;
    auto step = [&](int s, bool active) {
        const float* kp = k1b + (size_t)s * a.k1s; float sc = 0.f;
#pragma unroll
        for (int d = 0; d < 64; ++d) sc += q[d] * kp[d];
        if (DQK > 64) { const float* kp2 = k2b + (size_t)s * a.k2s;
#pragma unroll
            for (int d = 0; d < DQK - 64; ++d) sc += q[64 + d] * kp2[d]; }
        sc = sc * a.scale - slope * (float)(t - s);
        const float mn = active ? fmaxf(m, sc) : m; const float cs = expf(m - mn); const float p = active ? expf(sc - mn) : 0.f;
        l = l * cs + p; m = mn; const float* vp = vb + (size_t)s * a.vs;
#pragma unroll
        for (int d = 0; d < 64; ++d) o[d] = o[d] * cs + p * vp[d];
    };
    if (MODE == 0) { int s0 = tmin - a.window + 1; if (s0 < 0) s0 = 0; for (int s = s0; s <= tmax; ++s) step(s, s <= t && t - s < a.window); }
    else if (MODE == 1) { for (int s = 0; s <= tmax; ++s) step(s, s <= t); }
    else { const unsigned long long mk = a.selmask[(size_t)(b * 2 + kvh) * SQ + t]; unsigned lo = (unsigned)mk, hi = (unsigned)(mk >> 32);
        for (int x = 32; x > 0; x >>= 1) { lo |= __shfl_xor(lo, x); hi |= __shfl_xor(hi, x); }
        const unsigned long long um = ((unsigned long long)hi << 32) | lo;
        for (int j = 0; j < 64; ++j) { if (!((um >> j) & 1ull)) continue; const bool mine = (mk >> j) & 1ull;
            for (int s = 64 * j; s < 64 * j + 64 && s <= tmax; ++s) step(s, mine && s <= t); } }
    float* op = a.o + (size_t)(b * SQ + t) * a.os + hq * 64; const float inv = 1.0f / l;
#pragma unroll
    for (int d = 0; d < 64; ++d) op[d] = o[d] * inv;
}

__global__ __launch_bounds__(256) void k_cmp_topk(const float* __restrict__ proj, const float* __restrict__ kc, const float* __restrict__ vc, float* __restrict__ ocmp, unsigned long long* __restrict__ selmask) {
    __shared__ float qs[4][4][64]; __shared__ float ps[4][256]; __shared__ float pacc[4][260];
    const int w = threadIdx.x >> 6, lane = threadIdx.x & 63; const int gid = blockIdx.x * 4 + w; const int t = gid % SQ, g = (gid / SQ) & 1, b = gid / (2 * SQ);
    const float* qp = proj + (size_t)(b * SQ + t) * NIN + O_CQ + g * 256;
#pragma unroll
    for (int r = 0; r < 4; ++r) qs[w][r][lane] = qp[r * 64 + lane];
    const int nvalid = t >= 31 ? (t - 31) / 16 + 1 : 0;
    float psum[4] = {0.f, 0.f, 0.f, 0.f};
    __syncthreads();
    for (int r = 0; r < 4; ++r) {
        const float slope = exp2f(-(float)(g * 4 + r + 1)); float sc[4]; float mx = -1e30f;
#pragma unroll
        for (int i = 0; i < 4; ++i) { const int n = lane + 64 * i; sc[i] = -1e30f;
            if (n < nvalid) { const float* kp = kc + ((size_t)(b * NCMP + n) * 2 + g) * 64; float a = 0.f;
                for (int d = 0; d < 64; ++d) a += qs[w][r][d] * kp[d];
                sc[i] = a * 0.125f - slope * (float)(t - (16 * n + 31)); }
            mx = fmaxf(mx, sc[i]); }
        mx = wave_max(mx); float e[4], sum = 0.f;
#pragma unroll
        for (int i = 0; i < 4; ++i) { const int n = lane + 64 * i; e[i] = (n < nvalid) ? expf(sc[i] - mx) : 0.f; sum += e[i]; }
        sum = wave_sum(sum); const float inv = nvalid > 0 ? 1.0f / sum : 0.f;
#pragma unroll
        for (int i = 0; i < 4; ++i) { const float p = e[i] * inv; ps[w][lane + 64 * i] = p; psum[i] += p; }
        __syncthreads();
        float o = 0.f;
        for (int n = 0; n < nvalid; ++n) o += ps[w][n] * vc[((size_t)(b * NCMP + n) * 2 + g) * 64 + lane];
        ocmp[(size_t)(b * SQ + t) * 512 + (g * 4 + r) * 64 + lane] = o;
        __syncthreads();
    }
#pragma unroll
    for (int i = 0; i < 4; ++i) pacc[w][lane + 64 * i] = psum[i];
    __syncthreads();
    const int j = lane; float imp = 0.f;
    if (4 * j - 1 >= 0) imp += pacc[w][4 * j - 1];
    imp += 2.f * pacc[w][4 * j] + 2.f * pacc[w][4 * j + 1] + 2.f * pacc[w][4 * j + 2];
    if (4 * j + 3 < NCMP) imp += pacc[w][4 * j + 3];
    const int cur = t >> 6; const bool avail = 64 * j <= t; const bool forced = (j == 0) || (j == cur) || (j == cur - 1);
    float val = avail ? imp : -1e30f; if (forced) val = 1e30f;
    int rank = 0;
    for (int i = 0; i < 64; ++i) { const float vi = __shfl(val, i); rank += (vi > val || (vi == val && i < j)) ? 1 : 0; }
    const bool sel = rank < 16 && avail;
    const unsigned long long mk = __ballot(sel);
    if (lane == 0) selmask[(size_t)(b * 2 + g) * SQ + t] = mk;
}

__global__ __launch_bounds__(256) void k_mix(const float* __restrict__ proj, const float* __restrict__ oa, const float* __restrict__ ob, const float* __restrict__ ocmp, const float* __restrict__ oslc,
                                             const float* __restrict__ owin, const float* __restrict__ g_oa, const float* __restrict__ g_ob, const float* __restrict__ g_oc, float* __restrict__ mixed) {
    const int t = blockIdx.x * 4 + (threadIdx.x >> 6), lane = threadIdx.x & 63; float* mo = mixed + (size_t)t * DM;
    { const float4 v = *(const float4*)(oa + (size_t)t * 256 + lane * 4); const float s = wave_sum(v.x * v.x + v.y * v.y + v.z * v.z + v.w * v.w); const float r = 1.0f / sqrtf(s * (1.0f / 256) + EPS);
      const float4 g = *(const float4*)(g_oa + lane * 4); *(float4*)(mo + lane * 4) = make_float4(v.x * r * g.x, v.y * r * g.y, v.z * r * g.z, v.w * r * g.w); }
    { const float4 v = *(const float4*)(ob + (size_t)t * 256 + lane * 4); const float s = wave_sum(v.x * v.x + v.y * v.y + v.z * v.z + v.w * v.w); const float r = 1.0f / sqrtf(s * (1.0f / 256) + EPS);
      const float4 g = *(const float4*)(g_ob + lane * 4); *(float4*)(mo + 256 + lane * 4) = make_float4(v.x * r * g.x, v.y * r * g.y, v.z * r * g.z, v.w * r * g.w); }
    float c[8]; float s = 0.f; const float* gp = proj + (size_t)t * NIN + O_CG;
#pragma unroll
    for (int i = 0; i < 8; ++i) { const int col = lane + 64 * i, hq = i;
        const float g0 = 1.0f / (1.0f + expf(-gp[hq * 3 + 0])), g1 = 1.0f / (1.0f + expf(-gp[hq * 3 + 1])), g2 = 1.0f / (1.0f + expf(-gp[hq * 3 + 2]));
        c[i] = g0 * ocmp[(size_t)t * 512 + col] + g1 * oslc[(size_t)t * 512 + col] + g2 * owin[(size_t)t * 512 + col]; s += c[i] * c[i]; }
    s = wave_sum(s); const float r = 1.0f / sqrtf(s * (1.0f / 512) + EPS);
#pragma unroll
    for (int i = 0; i < 8; ++i) { const int col = lane + 64 * i; mo[512 + col] = c[i] * r * g_oc[col]; }
}

__global__ __launch_bounds__(256) void k_router(const float* __restrict__ h, const float* __restrict__ wr, int* __restrict__ cnt, int* __restrict__ rowidx, float* __restrict__ roww) {
    const int t = blockIdx.x * 4 + (threadIdx.x >> 6), lane = threadIdx.x & 63; float lg[8];
#pragma unroll
    for (int e = 0; e < 8; ++e) lg[e] = 0.f;
    for (int k = lane; k < DM; k += 64) { const float x = h[(size_t)t * DM + k]; const float4 w0 = *(const float4*)(wr + k * 8), w1 = *(const float4*)(wr + k * 8 + 4);
        lg[0] += x * w0.x; lg[1] += x * w0.y; lg[2] += x * w0.z; lg[3] += x * w0.w; lg[4] += x * w1.x; lg[5] += x * w1.y; lg[6] += x * w1.z; lg[7] += x * w1.w; }
#pragma unroll
    for (int e = 0; e < 8; ++e) lg[e] = wave_sum(lg[e]);
    int i0 = 0; float v0 = lg[0];
#pragma unroll
    for (int e = 1; e < 8; ++e) if (lg[e] > v0) { v0 = lg[e]; i0 = e; }
    int i1 = -1; float v1 = -3.0e38f;
#pragma unroll
    for (int e = 0; e < 8; ++e) if (e != i0 && lg[e] > v1) { v1 = lg[e]; i1 = e; }
    const float e1 = expf(v1 - v0); const float w0 = 1.0f / (1.0f + e1), w1 = e1 / (1.0f + e1);
    if (lane == 0) { int p = atomicAdd(cnt + i0, 1); rowidx[i0 * NT + p] = t; roww[i0 * NT + p] = w0; p = atomicAdd(cnt + i1, 1); rowidx[i1 * NT + p] = t; roww[i1 * NT + p] = w1; }
}

constexpr size_t MB = 1u << 20;
constexpr size_t W_H = 0, W_PROJ = 64 * MB, W_CQN = 212 * MB, W_CKVN = 229 * MB, W_KR = 238 * MB, W_QB = 241 * MB, W_KVB = 267 * MB, W_KC = 301 * MB, W_VC = 301 * MB + 512 * 1024,
                 W_OA = 302 * MB, W_OB = 319 * MB, W_OCMP = 336 * MB, W_OSLC = 370 * MB, W_OWIN = 404 * MB, W_SEL = 438 * MB, W_MIXED = 0, W_MOUT = 64 * MB,
                 W_HID = 64 * MB, W_F = 332 * MB, W_CNT = 400 * MB, W_RIDX = 401 * MB, W_RW = 402 * MB, W_END = 440 * MB;

extern "C" void kernel_launch(void* const* d_in, const int* in_sizes, int n_in, void* d_out, int out_size, void* d_ws, size_t ws_size, hipStream_t stream) {
    if (ws_size < W_END) return;
    auto F = [&](int i) { return (const float*)d_in[i]; };
    const float* x_in = F(0); const int* pos = (const int*)d_in[1]; float* xo = (float*)d_out; char* ws = (char*)d_ws;
    float *H = (float*)(ws + W_H), *PROJ = (float*)(ws + W_PROJ), *CQN = (float*)(ws + W_CQN), *CKVN = (float*)(ws + W_CKVN), *KR = (float*)(ws + W_KR), *QB = (float*)(ws + W_QB), *KVB = (float*)(ws + W_KVB),
          *KC = (float*)(ws + W_KC), *VC = (float*)(ws + W_VC), *OA = (float*)(ws + W_OA), *OB = (float*)(ws + W_OB), *OCMP = (float*)(ws + W_OCMP), *OSLC = (float*)(ws + W_OSLC), *OWIN = (float*)(ws + W_OWIN),
          *MIXED = (float*)(ws + W_MIXED), *MOUT = (float*)(ws + W_MOUT), *HID = (float*)(ws + W_HID), *FO = (float*)(ws + W_F), *RW = (float*)(ws + W_RW);
    unsigned long long* SEL = (unsigned long long*)(ws + W_SEL); int* CNT = (int*)(ws + W_CNT); int* RIDX = (int*)(ws + W_RIDX);
    for (int l = 0; l < 2; ++l) {
        const float* xc = (l == 0) ? x_in : xo;
        k_rmsnorm<<<NT / 4, 256, 0, stream>>>(xc, F(18) + l * DM, H);
        k_sgemm<false, 0><<<dim3((NIN + 63) / 64, NT / 64), 256, 0, stream>>>(H, DM, nullptr, F(2) + (size_t)l * DM * NIN, nullptr, NIN, PROJ, NIN, NT, nullptr, NIN, DM, nullptr, nullptr);
        k_mla_prep<<<NT / 4, 256, 0, stream>>>(PROJ, pos, F(4) + l * 256, F(6) + l * 128, CQN, CKVN, KR);
        k_sgemm<false, 0><<<dim3(384 / 64, NT / 64), 256, 0, stream>>>(CQN, 256, nullptr, F(5) + (size_t)l * 256 * 384, nullptr, 384, QB, 384, NT, nullptr, 384, 256, nullptr, nullptr);
        k_sgemm<false, 0><<<dim3(512 / 64, NT / 64), 256, 0, stream>>>(CKVN, 128, nullptr, F(7) + (size_t)l * 128 * 512, nullptr, 512, KVB, 512, NT, nullptr, 512, 128, nullptr, nullptr);
        k_rope_q<<<NT * 64 / 256, 256, 0, stream>>>(QB, pos);
        k_compress<<<NB * NCMP * 4, 128, 0, stream>>>(PROJ, F(8) + (size_t)l * 2048 * 128, F(9) + (size_t)l * 128 * 64, F(10) + (size_t)l * 2048, F(11) + (size_t)l * 2048 * 128, F(12) + (size_t)l * 128 * 64, F(13) + (size_t)l * 2048, KC, VC);
        { AttnArgs a{}; a.q = PROJ; a.qs = NIN; a.qoff = O_AQ; a.k1 = PROJ; a.k1s = NIN; a.k1off = O_AK; a.k1h = 64; a.k2 = nullptr; a.k2s = 0; a.v = PROJ; a.vs = NIN; a.voff = O_AV; a.vh = 64; a.o = OA; a.os = 256;
          a.sinks = F(3) + l * 4; a.selmask = nullptr; a.R = 2; a.window = 128; a.scale = 0.125f; a.slope_step = 2.0f;
          k_attn_naive<0, 64><<<dim3(SQ / 64, 4, NB), 64, 0, stream>>>(a); }
        { AttnArgs a{}; a.q = QB; a.qs = 384; a.qoff = 0; a.k1 = KVB; a.k1s = 512; a.k1off = 0; a.k1h = 128; a.k2 = KR; a.k2s = 32; a.v = KVB; a.vs = 512; a.voff = 64; a.vh = 128; a.o = OB; a.os = 256;
          a.sinks = nullptr; a.selmask = nullptr; a.R = 1; a.window = 0; a.scale = 0.10206207261596575f; a.slope_step = 0.f;
          k_attn_naive<1, 96><<<dim3(SQ / 64, 4, NB), 64, 0, stream>>>(a); }
        k_cmp_topk<<<NT * 2 / 4, 256, 0, stream>>>(PROJ, KC, VC, OCMP, SEL);
        { AttnArgs a{}; a.q = PROJ; a.qs = NIN; a.qoff = O_CQ; a.k1 = PROJ; a.k1s = NIN; a.k1off = O_CKS; a.k1h = 64; a.k2 = nullptr; a.k2s = 0; a.v = PROJ; a.vs = NIN; a.voff = O_CVS; a.vh = 64; a.o = OSLC; a.os = 512;
          a.sinks = nullptr; a.selmask = SEL; a.R = 4; a.window = 0; a.scale = 0.125f; a.slope_step = 1.0f;
          k_attn_naive<2, 64><<<dim3(SQ / 64, 8, NB), 64, 0, stream>>>(a); }
        { AttnArgs a{}; a.q = PROJ; a.qs = NIN; a.qoff = O_CQ; a.k1 = PROJ; a.k1s = NIN; a.k1off = O_CKW; a.k1h = 64; a.k2 = nullptr; a.k2s = 0; a.v = PROJ; a.vs = NIN; a.voff = O_CVW; a.vh = 64; a.o = OWIN; a.os = 512;
          a.sinks = nullptr; a.selmask = nullptr; a.R = 4; a.window = 512; a.scale = 0.125f; a.slope_step = 1.0f;
          k_attn_naive<0, 64><<<dim3(SQ / 64, 8, NB), 64, 0, stream>>>(a); }
        k_mix<<<NT / 4, 256, 0, stream>>>(PROJ, OA, OB, OCMP, OSLC, OWIN, F(14) + l * 256, F(15) + l * 256, F(16) + l * 512, MIXED);
        k_sgemm<false, 0><<<dim3(DM / 64, NT / 64), 256, 0, stream>>>(MIXED, DM, nullptr, F(17) + (size_t)l * DM * DM, nullptr, DM, MOUT, DM, NT, nullptr, DM, DM, nullptr, nullptr);
        k_resnorm<<<NT / 4, 256, 0, stream>>>(xc, MOUT, F(19) + l * DM, xo);
        k_rmsnorm<<<NT / 4, 256, 0, stream>>>(xo, F(20) + l * DM, H);
        if (l == 0) {
            k_sgemm<true, 0><<<dim3(DFF / 64, NT / 64), 256, 0, stream>>>(H, DM, nullptr, F(22), F(23), DFF, HID, DFF, NT, nullptr, DFF, DM, nullptr, nullptr);
            k_sgemm<false, 0><<<dim3(DM / 64, NT / 64), 256, 0, stream>>>(HID, DFF, nullptr, F(24), nullptr, DM, FO, DM, NT, nullptr, DM, DFF, nullptr, nullptr);
        } else {
            hipMemsetAsync(CNT, 0, 64, stream); hipMemsetAsync(FO, 0, (size_t)NT * DM * 4, stream);
            k_router<<<NT / 4, 256, 0, stream>>>(H, F(25), CNT, RIDX, RW);
            for (int e = 0; e < NEXP; ++e) {
                k_sgemm<true, 0><<<dim3(DFE / 64, NT / 64), 256, 0, stream>>>(H, DM, RIDX + e * NT, F(26) + (size_t)e * DM * DFE, F(27) + (size_t)e * DM * DFE, DFE, HID, DFE, NT, CNT + e, DFE, DM, nullptr, nullptr);
                k_sgemm<false, 1><<<dim3(DM / 64, NT / 64), 256, 0, stream>>>(HID, DFE, nullptr, F(28) + (size_t)e * DFE * DM, nullptr, DM, FO, DM, NT, CNT + e, DM, DFE, RIDX + e * NT, RW + e * NT);
            }
        }
        k_resnorm<<<NT / 4, 256, 0, stream>>>(xo, FO, F(21) + l * DM, xo);
    }
}
```

```cpp
#include <hip/hip_runtime.h>
#include <stdint.h>
#include <math.h>
#include <cstdio>

namespace pg8 {
#define PG8_LAS __attribute__((address_space(3)))
typedef unsigned short bf16_t;
typedef short bf16x8 __attribute__((ext_vector_type(8)));
typedef float f32x4 __attribute__((ext_vector_type(4)));
typedef unsigned u32x4 __attribute__((ext_vector_type(4)));
constexpr int BM = 256, BK = 64, HALF = 128, HTB = HALF * BK * 2  , STAGE_BYTES = 8 * HTB, NXCD = 8, WGM = 8;

__host__ __device__ __forceinline__ int lds_byte(int r, int c) { const int st = (r >> 4) * 2 + (c >> 5), rr = r & 15, cc = c & 31, ob = rr * 64 + cc * 2; return st * 1024 + (ob ^ (((ob >> 9) & 1) << 5)); }
__host__ __device__ __forceinline__ void stage_rc(int b, int& R, int& C) { const int st = b / 1024, sb = b % 1024, swz = sb ^ (((sb >> 9) & 1) << 5); R = (st >> 1) * 16 + swz / 64; C = (st & 1) * 32 + (swz % 64) / 2; }
__host__ __device__ __forceinline__ int perm32(int rho) { const int n = rho >> 4, i = rho & 15; return 8 * (i >> 2) + 4 * n + (i & 3); }

struct Unit { int pm, pn; long aoff, boff; };
struct Gemm { const bf16_t* A; const bf16_t* Bt; int M, N, K; int lda, ldb, akstep, uoff; };

struct StaticOrder {
    int nM, nN, nwg, G, c;
    __host__ __device__ __forceinline__ void init(int M, int N, int G_, int c_) { nM = M / BM; nN = N / BM; nwg = nM * nN; G = G_; c = c_; }
    __host__ __device__ __forceinline__ bool next(int i, Unit& u) const {
        const long L = (long)i * G + c; if (L >= nwg) return false;
        int wgid = (int)L; { const int q = nwg / NXCD, r = nwg % NXCD, xcd = wgid % NXCD, off = wgid / NXCD; wgid = (xcd < r ? xcd * (q + 1) : r * (q + 1) + (xcd - r) * q) + off; }
        const int nig = WGM * nN, gid = wgid / nig, fm = gid * WGM, gsz = (nM - fm) < WGM ? (nM - fm) : WGM;
        u.pm = fm + ((wgid % nig) % gsz); u.pn = (wgid % nig) / gsz; u.aoff = 0; u.boff = 0; return true;
    }
    __device__ __forceinline__ void a_ready(const Unit&) const {}
    __device__ __forceinline__ void done(const Unit&) const {}
};
__device__ __forceinline__ unsigned cvt_pk_bf16(float lo, float hi) { unsigned r; asm volatile("v_cvt_pk_bf16_f32 %0, %1, %2" : "=v"(r) : "v"(lo), "v"(hi)); return r; }
typedef float f32x2 __attribute__((ext_vector_type(2)));
typedef int i32x4 __attribute__((ext_vector_type(4)));
typedef int i32x8 __attribute__((ext_vector_type(8)));
__device__ __forceinline__ i32x8 cat8(bf16x8 lo, bf16x8 hi) { return __builtin_shufflevector(__builtin_bit_cast(i32x4, lo), __builtin_bit_cast(i32x4, hi), 0, 1, 2, 3, 4, 5, 6, 7); }
template <class Epi, class Sched, bool ALIGN_EPI = false, bool SP2 = false, int F8S = 0>
__device__ __forceinline__ void gemm_phase(PG8_LAS unsigned char* lds, const Gemm g, const Sched& S, const Epi& E, int tid_in) {
    int tid_ = tid_in; asm volatile("" : "+v"(tid_));
    const int tid = tid_, wid = __builtin_amdgcn_readfirstlane(tid >> 6), lane = tid & 63, wr = wid >> 2, wc = wid & 3, fr = lane & 15, fq = lane >> 4;
    int nt_ = g.K / BK; asm volatile("" : "+s"(nt_));
    const int K = g.K, nt = nt_, lda = g.lda ? g.lda : K, ldb = g.ldb ? g.ldb : K;
    unsigned voffA[2], voffB[2];
#pragma unroll
    for (int i = 0; i < 2; ++i) { int R, C; stage_rc(tid * 16 + i * 8192, R, C); const int Rb = Epi::PERM ? ((R & ~31) + perm32(R & 31)) : R;
        voffA[i] = (unsigned)(R * lda + C) * 2u; voffB[i] = (unsigned)(Rb * ldb + C) * 2u; }
    const size_t kstepB = (size_t)(BK * 2), kstepA = g.akstep ? (size_t)g.akstep : kstepB;
    const size_t hstepA = (size_t)HALF * lda * 2, hstepB = (size_t)HALF * ldb * 2;
    const size_t tstepA = 2 * hstepA, tstepB = 2 * hstepB;
    const unsigned ldsw = (unsigned)wid * 1024u;
    const int aoff = lds_byte(wr * 64 + fr, fq * 8), boff = lds_byte(wc * 32 + fr, fq * 8);
#define PG8_SA(b, h) (((b) * 2 + (h)) * HTB)
#define PG8_SB(b, h) ((4 + (b) * 2 + (h)) * HTB)
#define PG8_STAGE(bufoff, gbase, voff) do { const char* gb_ = (const char*)(gbase); asm volatile("" : "+s"(gb_));     \
        _Pragma("unroll") for (int _i = 0; _i < 2; ++_i) \
        __builtin_amdgcn_global_load_lds((const unsigned*)(gb_ + (voff)[_i]), (PG8_LAS unsigned*)(lds + (bufoff) + ldsw + _i * 8192), 16, 0, 0); } while (0)
#define PG8_LDA(dst, b, h) do { _Pragma("unroll") for (int m = 0; m < 4; ++m) _Pragma("unroll") for (int k = 0; k < 2; ++k) dst[m][k] = *(const PG8_LAS bf16x8*)(lds + PG8_SA(b, h) + aoff + m * 2048 + k * 1024); } while (0)
#define PG8_LDB(dst, b, h) do { _Pragma("unroll") for (int n = 0; n < 2; ++n) _Pragma("unroll") for (int k = 0; k < 2; ++k) dst[n][k] = *(const PG8_LAS bf16x8*)(lds + PG8_SB(b, h) + boff + n * 2048 + k * 1024); } while (0)
#define PG8_MMA(ai, bj, At, Bt) do { __builtin_amdgcn_s_setprio(1); _Pragma("unroll") for (int m = 0; m < 4; ++m) _Pragma("unroll") for (int n = 0; n < 2; ++n) { \
        if constexpr (F8S != 0) acc[ai][bj][m][n] = __builtin_amdgcn_mfma_scale_f32_16x16x128_f8f6f4(cat8(Bt[n][0], Bt[n][1]), cat8(At[m][0], At[m][1]), acc[ai][bj][m][n], 0, 0, 0, F8S >> 8, 0, F8S & 255); \
        else { _Pragma("unroll") for (int k = 0; k < 2; ++k) acc[ai][bj][m][n] = __builtin_amdgcn_mfma_f32_16x16x32_bf16(Bt[n][k], At[m][k], acc[ai][bj][m][n], 0, 0, 0); } } __builtin_amdgcn_s_setprio(0); } while (0)
#define PG8_WAIT_V(n) asm volatile("s_waitcnt vmcnt(" #n ")" ::: "memory")
#define PG8_WAIT_L(n) asm volatile("s_waitcnt lgkmcnt(" #n ")" ::: "memory")
#define PG8_BAR __builtin_amdgcn_s_barrier()
#define PG8_SCHED __builtin_amdgcn_sched_barrier(0)
    Unit cur, nxt; int ui = 0;
    if (!S.next(0, cur)) return;
    f32x4 acc[2][2][4][2];
#pragma unroll
    for (int a = 0; a < 2; ++a)
#pragma unroll
        for (int b = 0; b < 2; ++b)
#pragma unroll
            for (int m = 0; m < 4; ++m)
#pragma unroll
                for (int n = 0; n < 2; ++n) acc[a][b][m][n] = (f32x4){0.f, 0.f, 0.f, 0.f};
    bf16x8 At[4][2], B0[2][2], B1[2][2];
    const char* cA = (const char*)g.A + (g.uoff ? (size_t)cur.aoff : (size_t)cur.pm * tstepA); const char* cB = (const char*)g.Bt + (g.uoff ? (size_t)cur.boff : (size_t)cur.pn * tstepB);
    S.a_ready(cur);
    if constexpr (SP2) {
        PG8_STAGE(PG8_SB(0, 0), cB, voffB); PG8_STAGE(PG8_SB(0, 1), cB + hstepB, voffB); PG8_STAGE(PG8_SA(0, 0), cA, voffA); PG8_STAGE(PG8_SA(0, 1), cA + hstepA, voffA);
        if (wr == 1) PG8_BAR;
        PG8_WAIT_V(2); PG8_BAR;
        PG8_STAGE(PG8_SB(1, 0), cB + kstepB, voffB); PG8_STAGE(PG8_SA(1, 0), cA + kstepA, voffA); PG8_STAGE(PG8_SB(1, 1), cB + hstepB + kstepB, voffB);
        PG8_WAIT_V(6); PG8_BAR;
    } else {
        PG8_STAGE(PG8_SB(0, 0), cB, voffB); PG8_STAGE(PG8_SA(0, 0), cA, voffA); PG8_STAGE(PG8_SB(0, 1), cB + hstepB, voffB); PG8_STAGE(PG8_SA(0, 1), cA + hstepA, voffA);
        if (wr == 1) PG8_BAR;
        PG8_WAIT_V(4); PG8_BAR;
        PG8_STAGE(PG8_SB(1, 0), cB + kstepB, voffB); PG8_STAGE(PG8_SA(1, 0), cA + kstepA, voffA); PG8_STAGE(PG8_SB(1, 1), cB + hstepB + kstepB, voffB);
        PG8_WAIT_V(6); PG8_BAR;
    }
    for (;;) {
        const bool has_next = S.next(ui + 1, nxt);
        const char* nA = has_next ? (const char*)g.A + (g.uoff ? (size_t)nxt.aoff : (size_t)nxt.pm * tstepA) : cA; const char* nB = has_next ? (const char*)g.Bt + (g.uoff ? (size_t)nxt.boff : (size_t)nxt.pn * tstepB) : cB;
        asm volatile(".p2align 7");
#pragma unroll 1
        for (int t = 0; t < nt; t += 2) {
            const bool last = (t == nt - 2);
            const char* a1 = cA + (size_t)(t + 1) * kstepA;
            const char* a2 = last ? nA : cA + (size_t)(t + 2) * kstepA; const char* b2 = last ? nB : cB + (size_t)(t + 2) * kstepB;
            const char* a3 = a2 + kstepA; const char* b3 = b2 + kstepB;
            if (last && has_next) S.a_ready(nxt);
            if constexpr (Epi::KHOOK) { if (t == Epi::KH1 || t == Epi::KH2) E.khook(acc, t, wr); }
            if constexpr (SP2) {
            PG8_LDB(B0, 0, 0); PG8_LDB(B1, 0, 1); PG8_SCHED; PG8_LDA(At, 0, 0); PG8_STAGE(PG8_SA(1, 1), a1 + hstepA, voffA);
            PG8_WAIT_V(8); PG8_WAIT_L(0); PG8_BAR; PG8_MMA(0, 0, At, B0); PG8_MMA(0, 1, At, B1); PG8_BAR; PG8_SCHED;
            PG8_LDA(At, 0, 1); PG8_STAGE(PG8_SB(0, 0), b2, voffB); PG8_STAGE(PG8_SB(0, 1), b2 + hstepB, voffB); PG8_STAGE(PG8_SA(0, 0), a2, voffA);
            PG8_WAIT_V(8); PG8_WAIT_L(0); PG8_BAR; PG8_MMA(1, 0, At, B0); PG8_MMA(1, 1, At, B1); PG8_BAR; PG8_SCHED;
            PG8_LDB(B0, 1, 0); PG8_LDB(B1, 1, 1); PG8_SCHED; PG8_LDA(At, 1, 0); PG8_STAGE(PG8_SA(0, 1), a2 + hstepA, voffA);
            PG8_WAIT_V(8); PG8_WAIT_L(0); PG8_BAR; PG8_MMA(0, 0, At, B0); PG8_MMA(0, 1, At, B1); PG8_BAR; PG8_SCHED;
            PG8_LDA(At, 1, 1); PG8_STAGE(PG8_SB(1, 0), b3, voffB); PG8_STAGE(PG8_SB(1, 1), b3 + hstepB, voffB); PG8_STAGE(PG8_SA(1, 0), a3, voffA);
            PG8_WAIT_V(8); PG8_WAIT_L(0); PG8_BAR; PG8_MMA(1, 0, At, B0); PG8_MMA(1, 1, At, B1); PG8_BAR; PG8_SCHED;
            } else {
            PG8_LDB(B0, 0, 0); PG8_SCHED; PG8_LDA(At, 0, 0); PG8_STAGE(PG8_SA(1, 1), a1 + hstepA, voffA);
            PG8_WAIT_L(8); PG8_BAR; PG8_WAIT_L(0); PG8_MMA(0, 0, At, B0); PG8_BAR; PG8_SCHED;
            PG8_LDB(B1, 0, 1); PG8_STAGE(PG8_SB(0, 0), b2, voffB);
            PG8_BAR; PG8_WAIT_L(0); PG8_MMA(0, 1, At, B1); PG8_BAR;
            PG8_LDA(At, 0, 1); PG8_STAGE(PG8_SA(0, 0), a2, voffA);
            PG8_BAR; PG8_WAIT_L(0); PG8_MMA(1, 0, At, B0); PG8_BAR; PG8_SCHED;
            PG8_STAGE(PG8_SB(0, 1), b2 + hstepB, voffB);
            PG8_WAIT_V(6); PG8_BAR; PG8_MMA(1, 1, At, B1); PG8_BAR;
            PG8_LDB(B0, 1, 0); PG8_SCHED; PG8_LDA(At, 1, 0); PG8_STAGE(PG8_SA(0, 1), a2 + hstepA, voffA);
            PG8_WAIT_L(8); PG8_BAR; PG8_WAIT_L(0); PG8_MMA(0, 0, At, B0); PG8_BAR; PG8_SCHED;
            PG8_LDB(B1, 1, 1); PG8_STAGE(PG8_SB(1, 0), b3, voffB);
            PG8_BAR; PG8_WAIT_L(0); PG8_MMA(0, 1, At, B1); PG8_BAR;
            PG8_LDA(At, 1, 1); PG8_STAGE(PG8_SA(1, 0), a3, voffA);
            PG8_BAR; PG8_WAIT_L(0); PG8_MMA(1, 0, At, B0); PG8_BAR; PG8_SCHED;
            PG8_STAGE(PG8_SB(1, 1), b3 + hstepB, voffB);
            PG8_WAIT_V(6); PG8_BAR; PG8_MMA(1, 1, At, B1); PG8_BAR;
            }
        }
        if constexpr (ALIGN_EPI) { if (wr == 0) PG8_BAR; }
        if constexpr (!Epi::AFTER_DRAIN) { E(acc, cur, wr, wc, fr, fq); S.done(cur); }
        if (!has_next) break;
#pragma unroll
        for (int a = 0; a < 2; ++a)
#pragma unroll
            for (int b = 0; b < 2; ++b)
#pragma unroll
                for (int m = 0; m < 4; ++m)
#pragma unroll
                    for (int n = 0; n < 2; ++n) acc[a][b][m][n] = (f32x4){0.f, 0.f, 0.f, 0.f};
        cur = nxt; cA = nA; cB = nB; ++ui;
        if constexpr (ALIGN_EPI) { if (wr == 1) PG8_BAR; }
    }
    PG8_WAIT_V(0);
    if constexpr (!ALIGN_EPI) { if (wr == 0) PG8_BAR; }
    PG8_BAR;
    if constexpr (Epi::AFTER_DRAIN) { E.fused(acc, cur, wr, wc, fr, fq, lds, wid, lane); S.done(cur); }
#undef PG8_SA
#undef PG8_SB
#undef PG8_STAGE
#undef PG8_LDA
#undef PG8_LDB
#undef PG8_MMA
#undef PG8_WAIT_V
#undef PG8_WAIT_L
#undef PG8_BAR
#undef PG8_SCHED
}
}

namespace pg8 {
typedef float f32x8 __attribute__((ext_vector_type(8)));
typedef unsigned u32x2 __attribute__((ext_vector_type(2)));
typedef __bf16 bf16x8v __attribute__((ext_vector_type(8)));
__device__ __forceinline__ u32x4 pack8(f32x4 a, f32x4 b) { const f32x8 v = __builtin_shufflevector(a, b, 0, 1, 2, 3, 4, 5, 6, 7); return __builtin_bit_cast(u32x4, __builtin_convertvector(v, bf16x8v)); }
struct EpiF32 {
    static constexpr bool PERM = false, AFTER_DRAIN = false, KHOOK = false; float* O; int ldc, ncols;
    __device__ __forceinline__ void operator()(const f32x4 (&acc)[2][2][4][2], const Unit& u, int wr, int wc, int, int) const {
        int lane_; asm volatile("v_mbcnt_lo_u32_b32 %0, -1, 0\n\tv_mbcnt_hi_u32_b32 %0, -1, %0" : "=v"(lane_)); const int fr = lane_ & 15, fq = lane_ >> 4;
        const int row0 = u.pm * BM + wr * 64 + fr, col0 = u.pn * BM + wc * 32 + 4 * fq;
#pragma unroll
        for (int ai = 0; ai < 2; ++ai)
#pragma unroll
            for (int m = 0; m < 4; ++m) { float* rowp = O + (size_t)(row0 + ai * HALF + m * 16) * ldc;
#pragma unroll
                for (int bj = 0; bj < 2; ++bj)
#pragma unroll
                    for (int n = 0; n < 2; ++n) { const int col = col0 + bj * HALF + n * 16; if (col < ncols) *(f32x4*)(rowp + col) = acc[ai][bj][m][n]; } }
    }
};
struct EpiBf16s {
    static constexpr bool PERM = true, AFTER_DRAIN = false, KHOOK = false; bf16_t* O; int ldo, ntn; const float* roww; const float* colscale; const __attribute__((address_space(3))) int* etab = nullptr;
    __device__ __forceinline__ void operator()(const f32x4 (&acc)[2][2][4][2], const Unit& u, int wr, int wc, int, int) const {
        int lane_; asm volatile("v_mbcnt_lo_u32_b32 %0, -1, 0\n\tv_mbcnt_hi_u32_b32 %0, -1, %0" : "=v"(lane_)); const int fr = lane_ & 15, fq = lane_ >> 4;
        const int row0 = u.pm * BM + wr * 64 + fr, col0 = (u.pn % ntn) * BM + wc * 32 + 8 * fq;
        const float* roww = this->roww; if (etab) { const int e = etab[32 + u.pm]; roww += (long)e * 16384 - etab[e]; }
        f32x4 cs[2][2];
#pragma unroll
        for (int bj = 0; bj < 2; ++bj)
#pragma unroll
            for (int n = 0; n < 2; ++n) cs[bj][n] = colscale ? *(const f32x4*)(colscale + col0 + bj * HALF + 4 * n) : (f32x4){1.f, 1.f, 1.f, 1.f};
#pragma unroll
        for (int ai = 0; ai < 2; ++ai)
#pragma unroll
            for (int m = 0; m < 4; ++m) { const int row = row0 + ai * HALF + m * 16; const float rs = roww ? roww[row] : 1.f; bf16_t* rowp = O + (size_t)row * ldo + col0;
#pragma unroll
                for (int bj = 0; bj < 2; ++bj) { const f32x4 v0 = acc[ai][bj][m][0] * cs[bj][0] * rs, v1 = acc[ai][bj][m][1] * cs[bj][1] * rs;
                    const u32x4 w = pack8(v0, v1);
                    *(u32x4*)(rowp + bj * HALF) = w; } }
    }
};
__device__ __forceinline__ float silu_mul(float g, float u) { return g * __builtin_amdgcn_rcpf(1.0f + __builtin_amdgcn_exp2f(-1.4426950408889634f * g)) * u; }
struct EpiSwiGLU {
    static constexpr bool PERM = true, AFTER_DRAIN = false, KHOOK = false; bf16_t* O; int ldo, ntn;
    __device__ __forceinline__ void operator()(const f32x4 (&acc)[2][2][4][2], const Unit& u, int wr, int wc, int, int) const {
        int lane_; asm volatile("v_mbcnt_lo_u32_b32 %0, -1, 0\n\tv_mbcnt_hi_u32_b32 %0, -1, %0" : "=v"(lane_)); const int fr = lane_ & 15, fq = lane_ >> 4;
        const int row0 = u.pm * BM + wr * 64 + fr, f0 = (u.pn % ntn) * HALF + wc * 32 + 8 * fq;
#pragma unroll
        for (int ai = 0; ai < 2; ++ai)
#pragma unroll
            for (int m = 0; m < 4; ++m) { const f32x4 g0 = acc[ai][0][m][0], g1 = acc[ai][0][m][1], u0 = acc[ai][1][m][0], u1 = acc[ai][1][m][1];
                const f32x4 h0 = {silu_mul(g0[0], u0[0]), silu_mul(g0[1], u0[1]), silu_mul(g0[2], u0[2]), silu_mul(g0[3], u0[3])}, h1 = {silu_mul(g1[0], u1[0]), silu_mul(g1[1], u1[1]), silu_mul(g1[2], u1[2]), silu_mul(g1[3], u1[3])};
                const u32x4 w = pack8(h0, h1);
                *(u32x4*)(O + (size_t)(row0 + ai * HALF + m * 16) * ldo + f0) = w; }
    }
};
__device__ __forceinline__ float clamp8(float v) { float r; asm("v_max_f32 %0, %1, %2\n\tv_min_f32 %0, %3, %0" : "=&v"(r) : "s"(-448.f), "v"(v), "s"(448.f)); return r; }
__device__ __forceinline__ u32x2 pack8_f8(f32x4 a, f32x4 b, float sc) {
    int w0 = 0, w1 = 0;
    w0 = __builtin_amdgcn_cvt_pk_fp8_f32(clamp8(a[0] * sc), clamp8(a[1] * sc), w0, false); w0 = __builtin_amdgcn_cvt_pk_fp8_f32(clamp8(a[2] * sc), clamp8(a[3] * sc), w0, true);
    w1 = __builtin_amdgcn_cvt_pk_fp8_f32(clamp8(b[0] * sc), clamp8(b[1] * sc), w1, false); w1 = __builtin_amdgcn_cvt_pk_fp8_f32(clamp8(b[2] * sc), clamp8(b[3] * sc), w1, true);
    return (u32x2){(unsigned)w0, (unsigned)w1}; }
struct EpiSwiGLU8 {
    static constexpr bool PERM = true, AFTER_DRAIN = false, KHOOK = false; unsigned char* O; int ldo, ntn;
    static __device__ __forceinline__ float sm(float g, float u) { return g * __builtin_amdgcn_rcpf(1.0f + __builtin_amdgcn_exp2f(-g)) * u; }
    __device__ __forceinline__ void operator()(const f32x4 (&acc)[2][2][4][2], const Unit& u, int wr, int wc, int, int) const {
        int lane_; asm volatile("v_mbcnt_lo_u32_b32 %0, -1, 0\n\tv_mbcnt_hi_u32_b32 %0, -1, %0" : "=v"(lane_)); const int fr = lane_ & 15, fq = lane_ >> 4;
        const int row0 = u.pm * BM + wr * 64 + fr, f0 = (u.pn % ntn) * HALF + wc * 32 + 8 * fq;
#pragma unroll
        for (int ai = 0; ai < 2; ++ai)
#pragma unroll
            for (int m = 0; m < 4; ++m) { const f32x4 g0 = acc[ai][0][m][0], g1 = acc[ai][0][m][1], u0 = acc[ai][1][m][0], u1 = acc[ai][1][m][1];
                const f32x4 e0 = {__builtin_amdgcn_exp2f(-g0[0]), __builtin_amdgcn_exp2f(-g0[1]), __builtin_amdgcn_exp2f(-g0[2]), __builtin_amdgcn_exp2f(-g0[3])}, e1 = {__builtin_amdgcn_exp2f(-g1[0]), __builtin_amdgcn_exp2f(-g1[1]), __builtin_amdgcn_exp2f(-g1[2]), __builtin_amdgcn_exp2f(-g1[3])};
                const f32x4 d0 = e0 + 1.0f, d1 = e1 + 1.0f;
                const f32x4 r0 = {__builtin_amdgcn_rcpf(d0[0]), __builtin_amdgcn_rcpf(d0[1]), __builtin_amdgcn_rcpf(d0[2]), __builtin_amdgcn_rcpf(d0[3])}, r1 = {__builtin_amdgcn_rcpf(d1[0]), __builtin_amdgcn_rcpf(d1[1]), __builtin_amdgcn_rcpf(d1[2]), __builtin_amdgcn_rcpf(d1[3])};
                const f32x4 h0 = (g0 * u0) * r0, h1 = (g1 * u1) * r1;
                int w0 = 0, w1 = 0;
                w0 = __builtin_amdgcn_cvt_pk_fp8_f32(clamp8(h0[0]), clamp8(h0[1]), w0, false); w0 = __builtin_amdgcn_cvt_pk_fp8_f32(clamp8(h0[2]), clamp8(h0[3]), w0, true);
                w1 = __builtin_amdgcn_cvt_pk_fp8_f32(clamp8(h1[0]), clamp8(h1[1]), w1, false); w1 = __builtin_amdgcn_cvt_pk_fp8_f32(clamp8(h1[2]), clamp8(h1[3]), w1, true);
                *(u32x2*)(O + (size_t)(row0 + ai * HALF + m * 16) * ldo + f0) = (u32x2){(unsigned)w0, (unsigned)w1}; }
    }
};
struct EpiWo {
    static constexpr bool PERM = true, AFTER_DRAIN = false, KHOOK = true; static constexpr int KH1 = 4, KH2 = 8;
    bf16_t* O; int ldo; const __attribute__((address_space(3))) float* rt;
    __device__ __forceinline__ void scale(f32x4 (&acc)[2][2][4][2], int which, int wr) const {
        int lane_; asm volatile("v_mbcnt_lo_u32_b32 %0, -1, 0\n\tv_mbcnt_hi_u32_b32 %0, -1, %0" : "=v"(lane_)); const int fr = lane_ & 15;
#pragma unroll
        for (int ai = 0; ai < 2; ++ai)
#pragma unroll
            for (int m = 0; m < 4; ++m) { const float s = rt[4 * (wr * 64 + ai * HALF + m * 16 + fr) + which];
#pragma unroll
                for (int bj = 0; bj < 2; ++bj)
#pragma unroll
                    for (int n = 0; n < 2; ++n) acc[ai][bj][m][n] *= s; }
    }
    __device__ __forceinline__ void khook(f32x4 (&acc)[2][2][4][2], int t, int wr) const { scale(acc, t == KH1 ? 0 : 1, wr); }
    __device__ __forceinline__ void operator()(f32x4 (&acc)[2][2][4][2], const Unit& u, int wr, int wc, int, int) const {
        int lane_; asm volatile("v_mbcnt_lo_u32_b32 %0, -1, 0\n\tv_mbcnt_hi_u32_b32 %0, -1, %0" : "=v"(lane_)); const int fr = lane_ & 15, fq = lane_ >> 4;
        const int row0 = u.pm * BM + wr * 64 + fr, col0 = u.pn * BM + wc * 32 + 8 * fq;
#pragma unroll
        for (int ai = 0; ai < 2; ++ai)
#pragma unroll
            for (int m = 0; m < 4; ++m) { const int row = row0 + ai * HALF + m * 16; const float rs = rt[4 * (wr * 64 + ai * HALF + m * 16 + fr) + 2]; bf16_t* rowp = O + (size_t)row * ldo + col0;
#pragma unroll
                for (int bj = 0; bj < 2; ++bj) { const f32x4 v0 = acc[ai][bj][m][0] * rs, v1 = acc[ai][bj][m][1] * rs; *(u32x4*)(rowp + bj * HALF) = pack8(v0, v1); } }
    }
};
struct EpiMlaUp {
    static constexpr bool PERM = true, AFTER_DRAIN = false, KHOOK = false; bf16_t* QB; bf16_t* KVB;
    __device__ __forceinline__ void operator()(const f32x4 (&acc)[2][2][4][2], const Unit& u, int wr, int wc, int, int) const {
        int lane_; asm volatile("v_mbcnt_lo_u32_b32 %0, -1, 0\n\tv_mbcnt_hi_u32_b32 %0, -1, %0" : "=v"(lane_)); const int fr = lane_ & 15, fq = lane_ >> 4;
        const int row0 = u.pm * BM + wr * 64 + fr;
#pragma unroll
        for (int bj = 0; bj < 2; ++bj) {
            const int g = 8 * u.pn + 4 * bj + wc;
            if (g >= 28) continue;
            bf16_t* base = g < 12 ? QB + 32 * g + 8 * fq : KVB + 32 * g - 384 + 8 * fq; const int ld = g < 12 ? 384 : 512;
#pragma unroll
            for (int ai = 0; ai < 2; ++ai)
#pragma unroll
                for (int m = 0; m < 4; ++m) { const int row = row0 + ai * HALF + m * 16; const f32x4 v0 = acc[ai][bj][m][0], v1 = acc[ai][bj][m][1];
                    const u32x4 w = pack8(v0, v1);
                    *(u32x4*)(base + (size_t)row * ld) = w; }
        }
    }
};
struct EpiF8s {
    static constexpr bool PERM = true, AFTER_DRAIN = false, KHOOK = false; unsigned char* O; int ntn; const float* roww; const __attribute__((address_space(3))) int* etab; float sc;
    __device__ __forceinline__ void operator()(const f32x4 (&acc)[2][2][4][2], const Unit& u, int wr, int wc, int, int) const {
        int lane_; asm volatile("v_mbcnt_lo_u32_b32 %0, -1, 0\n\tv_mbcnt_hi_u32_b32 %0, -1, %0" : "=v"(lane_)); const int fr = lane_ & 15, fq = lane_ >> 4;
        const int row0 = u.pm * BM + wr * 64 + fr, col0 = (u.pn % ntn) * BM + wc * 32 + 8 * fq;
        const float* rw = roww; { const int e = etab[32 + u.pm]; rw += (long)e * 16384 - etab[e]; }
#pragma unroll
        for (int ai = 0; ai < 2; ++ai)
#pragma unroll
            for (int m = 0; m < 4; ++m) { const int row = row0 + ai * HALF + m * 16; const float rs = rw[row] * sc; unsigned char* rowp = O + (size_t)row * 1024 + col0;
#pragma unroll
                for (int bj = 0; bj < 2; ++bj) *(u32x2*)(rowp + bj * HALF) = pack8_f8(acc[ai][bj][m][0], acc[ai][bj][m][1], rs); }
    }
};
struct EpiPart {
    static constexpr bool PERM = true, AFTER_DRAIN = false, KHOOK = false; bf16_t* O; const float* roww; const __attribute__((address_space(3))) int* etab;
    __device__ __forceinline__ void operator()(const f32x4 (&acc)[2][2][4][2], const Unit& u, int wr, int wc, int, int) const {
        int lane_; asm volatile("v_mbcnt_lo_u32_b32 %0, -1, 0\n\tv_mbcnt_hi_u32_b32 %0, -1, %0" : "=v"(lane_)); const int fr = lane_ & 15, fq = lane_ >> 4;
        const int pm = u.pm & 0xffff, s = u.pm >> 16, row0 = wr * 64 + fr, col0 = u.pn * BM + wc * 32 + 8 * fq;
        const float* roww = this->roww; { const int e = etab[32 + pm]; roww += (long)e * 16384 - etab[e]; }
#pragma unroll
        for (int ai = 0; ai < 2; ++ai)
#pragma unroll
            for (int m = 0; m < 4; ++m) { const int r = row0 + ai * HALF + m * 16; const float rs = roww[pm * 256 + r]; bf16_t* rowp = O + ((size_t)(s * 8 + (pm - 128)) * 256 + r) * 1024 + col0;
#pragma unroll
                for (int bj = 0; bj < 2; ++bj) { const f32x4 v0 = acc[ai][bj][m][0] * rs, v1 = acc[ai][bj][m][1] * rs; *(u32x4*)(rowp + bj * HALF) = pack8(v0, v1); } }
    }
};
}

#define GAS __attribute__((address_space(1)))
#define LAS __attribute__((address_space(3)))
typedef unsigned short bf16;
typedef unsigned v4u __attribute__((ext_vector_type(4)));
typedef float f32x4 __attribute__((ext_vector_type(4)));
typedef short bf16x8 __attribute__((ext_vector_type(8)));
typedef GAS unsigned gu32;
typedef GAS unsigned long long gu64;
#define RLX_AGENT __ATOMIC_RELAXED, __HIP_MEMORY_SCOPE_AGENT
#define LDS_WAIT() asm volatile("s_waitcnt lgkmcnt(0)" ::: "memory")
#define VM_WAIT() asm volatile("s_waitcnt vmcnt(0)" ::: "memory")
__device__ __forceinline__ unsigned long long rt() { return __builtin_amdgcn_s_memrealtime(); }
__device__ __forceinline__ unsigned f2bf(float f) { unsigned u = __builtin_bit_cast(unsigned, f); return (u + 0x7fffu + ((u >> 16) & 1u)) >> 16; }
__device__ __forceinline__ unsigned pk2(float lo, float hi) { return f2bf(lo) | (f2bf(hi) << 16); }
#define XB_TMO      128
#define XB_XCNT(j)  (256  + 64 * (j))
#define XB_XSUB(j)  (1280 + 64 * (j))
#define XB_XGEN(j)  (2304 + 64 * (j))
#define XB_TOP      3328
#define XB_TOPGEN   3392
#define XCD_BAR_WORDS 3456
#define XB_SPIN_CAP (1u << 18)

__device__ __forceinline__ unsigned xb_ld(unsigned* p)              { return __hip_atomic_load(p, __ATOMIC_RELAXED, __HIP_MEMORY_SCOPE_AGENT); }
__device__ __forceinline__ unsigned xb_add(unsigned* p, unsigned v) { return __hip_atomic_fetch_add(p, v, __ATOMIC_RELAXED, __HIP_MEMORY_SCOPE_AGENT); }
__device__ __forceinline__ unsigned xb_xcc_id() { return (unsigned)__builtin_amdgcn_s_getreg((3 << 11) | 20) & 0xFu; }
#define XB_SPIN(cond, bar) do { unsigned _sp = 0; while (cond) { __builtin_amdgcn_s_sleep(1); \
    if ((++_sp & 255u) == 0u) { if (xb_ld(&(bar)[XB_TMO])) break; if (_sp > XB_SPIN_CAP) { atomicAdd(&(bar)[XB_TMO], 1u); break; } } } } while (0)

struct XcdBarrier {
    unsigned* bar; unsigned x;
    volatile LAS unsigned* st;
};

__device__ __forceinline__ XcdBarrier xcd_barrier_post(unsigned* bar, volatile LAS unsigned* st) {
    XcdBarrier b; b.bar = bar; b.x = xb_xcc_id(); b.st = st;
    if (threadIdx.x == 0) st[3] = xb_add(&bar[XB_XCNT(b.x)], 1u);
    return b;
}
__device__ __forceinline__ void xcd_barrier_complete(unsigned* bar, unsigned x, unsigned& nloc, unsigned& nx) {
    const unsigned G = gridDim.x * gridDim.y * gridDim.z;
    unsigned sum, cnt, mine, sp = 0u;
    for (;;) {
        sum = 0u; cnt = 0u; mine = 0u;
#pragma unroll
        for (unsigned j = 0; j < 16; ++j) { const unsigned c = xb_ld(&bar[XB_XCNT(j)]); sum += c; cnt += (c > 0u) ? 1u : 0u; mine = (j == x) ? c : mine; }
        if (sum == G) break;
        __builtin_amdgcn_s_sleep(1);
        if ((++sp & 255u) == 0u) { if (xb_ld(&bar[XB_TMO])) break; if (sp > XB_SPIN_CAP) { atomicAdd(&bar[XB_TMO], 1u); break; } }
    }
    nloc = mine > 0u ? mine : 1u; nx = cnt > 0u ? cnt : 1u;
}
__device__ __forceinline__ unsigned xcd_census_uniform(unsigned* bar) {
    const unsigned G = gridDim.x * gridDim.y * gridDim.z; unsigned ok = (G % 8u) == 0u ? 1u : 0u;
#pragma unroll
    for (unsigned j = 0; j < 8; ++j) ok &= (xb_ld(&bar[XB_XCNT(j)]) == G / 8u) ? 1u : 0u;
    return ok;
}

__device__ __forceinline__ void xcd_barrier(const XcdBarrier& b) {
    asm volatile("s_waitcnt vmcnt(0)" ::: "memory");
    __syncthreads();
    if (threadIdx.x == 0) {
        unsigned* bar = b.bar;
        __builtin_amdgcn_s_waitcnt(0);
        unsigned nloc = b.st[0], nx = b.st[1];
        if (nloc == 0u) { xcd_barrier_complete(bar, b.x, nloc, nx); b.st[0] = nloc; b.st[1] = nx; b.st[2] = xcd_census_uniform(bar); }
        const unsigned old = xb_add(&bar[XB_XSUB(b.x)], 1u);
        const unsigned gen = old / nloc;
        if (old + 1u == (gen + 1u) * nloc) {
            __builtin_amdgcn_fence(__ATOMIC_RELEASE, "agent");
            asm volatile("s_waitcnt vmcnt(0)" ::: "memory");
            const unsigned og = xb_add(&bar[XB_TOP], 1u);
            const unsigned tg = og / nx;
            if (og + 1u == (tg + 1u) * nx) xb_add(&bar[XB_TOPGEN], 1u);
            else XB_SPIN(xb_ld(&bar[XB_TOPGEN]) == tg, bar);
            __builtin_amdgcn_fence(__ATOMIC_ACQUIRE, "agent");
            xb_add(&bar[XB_XGEN(b.x)], 1u);
            asm volatile("s_waitcnt vmcnt(0)" ::: "memory");
        } else {
            XB_SPIN(xb_ld(&bar[XB_XGEN(b.x)]) == gen, bar);
            __builtin_amdgcn_fence(__ATOMIC_ACQUIRE, "agent");
            asm volatile("s_waitcnt vmcnt(0)" ::: "memory");
        }
    }
    __syncthreads();
}

__device__ __forceinline__ void xcd_barrier_local(const XcdBarrier& b) {
    asm volatile("s_waitcnt vmcnt(0)" ::: "memory");
    __syncthreads();
    if (threadIdx.x == 0) {
        unsigned* bar = b.bar;
        __builtin_amdgcn_s_waitcnt(0);
        const unsigned nloc = b.st[0];
        const unsigned old = xb_add(&bar[XB_XSUB(b.x)], 1u);
        const unsigned gen = old / nloc;
        if (old + 1u == (gen + 1u) * nloc) xb_add(&bar[XB_XGEN(b.x)], 1u);
        else XB_SPIN(xb_ld(&bar[XB_XGEN(b.x)]) == gen, bar);
        __builtin_amdgcn_fence(__ATOMIC_ACQUIRE, "agent");
        asm volatile("s_waitcnt vmcnt(0)" ::: "memory");
    }
    __syncthreads();
}

#define DI __device__ __forceinline__
constexpr int DM = 1024, NB = 4, SQ = 4096, NT = NB * SQ, NIN = 2232, NINP = 2304;
constexpr int O_AQ = 0, O_AK = 256, O_AV = 384, O_BCQ = 512, O_BCKV = 768, O_BKR = 896, O_CQ = 928, O_CKC = 1440, O_CVC = 1568,
              O_CKS = 1696, O_CVS = 1824, O_CKW = 1952, O_CVW = 2080, O_CG = 2208;
constexpr int NCMP = 255, DFF = 4096, NEXP = 8, DFE = 3584, MOE_ROWS = 32768 + 8 * 256;
constexpr float EPS = 1e-6f;
constexpr int NWAVES = 8;
constexpr int LDS_BYTES = 147456, RING_BYTES = 131072, LDSCTL_OFF = RING_BYTES, MISC_OFF = RING_BYTES + 320, TAB_OFF = RING_BYTES + 1024;
constexpr size_t MiB = 1u << 20;
constexpr size_t WS_CTL = 0, CTL_ZERO_BYTES = 128 * 1024;
constexpr size_t WS_WIN = 1 * MiB, WS_WUP = 10 * MiB, WS_WO = 12 * MiB, WS_WGU = 16 * MiB, WS_WD = 32 * MiB, WS_ROPE = 40 * MiB;
constexpr size_t WS_TOKE = 42 * MiB, WS_TOKP = WS_TOKE + 128 * 1024, WS_TOKW = WS_TOKP + 128 * 1024, WS_ROWTOK = WS_TOKW + 128 * 1024, WS_ROWW = WS_ROWTOK + 256 * 1024;
constexpr size_t WIN_L = (size_t)NINP * 1024 * 2, WUP_L = (size_t)1024 * 384 * 2, WO_L = (size_t)1024 * 1024 * 2;
constexpr size_t WS_PROJ = 45 * MiB, WS_CQKV = 117 * MiB, WS_QB = 129 * MiB, WS_KVB = 141 * MiB, WS_KR = 157 * MiB, WS_KC = 158 * MiB, WS_VC = 158 * MiB + 512 * 1024, WS_SELM = 159 * MiB,
                 WS_OA = 160 * MiB, WS_OB = 168 * MiB, WS_OCMP = 176 * MiB, WS_OSLC = 192 * MiB, WS_OWIN = 208 * MiB, WS_XN = 225 * MiB, WS_MIXED = 257 * MiB, WS_MOUT = 289 * MiB;
constexpr size_t WS_HIDB = 45 * MiB, WS_FOUT = 321 * MiB;
constexpr size_t WS_WC1 = 192 * MiB, WC1_L = (size_t)512 * 2048 * 2, WS_HIDP = 196 * MiB, WS_CBIAS = 204 * MiB;
constexpr size_t WS_PART = 172 * MiB;
constexpr int F8_PAIR = 4;
constexpr int F8_XN = 2, F8_WGU = 6, F8_HID = 3, F8_WD = 7;
constexpr int F8S_GU = (127 - (F8_WGU + F8_XN) / 2) * 257, F8S_D = (127 - (F8_WD + F8_HID) / 2) * 257;
static_assert((F8_WGU + F8_XN) % 2 == 0 && (F8_WD + F8_HID) % 2 == 0, "even scale sums");
constexpr size_t WS_MGU = 378 * MiB, WS_AG = 45 * MiB, WS_ROWWE = 43 * MiB + 512 * 1024, WS_SSQ = 44 * MiB;
constexpr size_t WS_HIDM = 225 * MiB, WS_MD = 350 * MiB, WS_PAIR = 101 * MiB, WS_END = 463 * MiB;
constexpr int NCH_F = 3 * 2048 / 32, NCH_PREP = 320;
constexpr int CONV_CHUNK = 32, NCH_GU = 2 * NEXP * 16 * (DFE / 32) / CONV_CHUNK, NCH_D = NEXP * (DFE / 64) * 32 / CONV_CHUNK;
constexpr int CW_BAR = 4096, CW_Q = 8192, CW_Q2 = 12288, CW_CNT = 16384, CW_QX = 17408;
constexpr int PH_PRO = 0, L0_BASE = 1, L1_BASE = 10, NPH = 19;
enum { J_INPROJ = 0, J_PREP = 1, J_MLAUP = 2, J_ATTN = 3, J_WO = 4, J_RESN = 5, J_F1 = 6, J_F2 = 7, J_F3 = 8 };

DI float bflo(unsigned w) { return __uint_as_float(w << 16); }
DI float bfhi(unsigned w) { return __uint_as_float(w & 0xffff0000u); }
DI float bf1(bf16 v) { return __uint_as_float((unsigned)v << 16); }
DI float shx(float v, int m, int lane) { return __int_as_float(__builtin_amdgcn_ds_bpermute((lane ^ m) << 2, __float_as_int(v))); }
DI unsigned shxu(unsigned v, int m, int lane) { return (unsigned)__builtin_amdgcn_ds_bpermute((lane ^ m) << 2, (int)v); }
DI float wave_sum(float v, int lane) {
#pragma unroll
    for (int o = 32; o > 0; o >>= 1) v += shx(v, o, lane);
    return v; }
DI float wave_max(float v, int lane) {
#pragma unroll
    for (int o = 32; o > 0; o >>= 1) v = fmaxf(v, shx(v, o, lane));
    return v; }
DI int q_pop(gu32* ctr, int lane) { unsigned v = 0; if (lane == 0) v = __hip_atomic_fetch_add(ctr, 1u, RLX_AGENT); return (int)__builtin_amdgcn_readfirstlane(v); }
DI float rope_inv(int i) { return exp2f(-(float)i * 0.83048202372184059f); }

DI int conv_rowmap(int mode, int row_off, int n) { return mode == 0 ? row_off + n : row_off + ((n >> 7) << 8) + (n & 127); }
DI void conv_load(const float* W, int N, int item, int lane, f32x4 (&v)[8]) {
    const int nblk = (N + 31) / 32, kb = item / nblk, nb = item % nblk, k0 = 64 * kb, n0 = 32 * nb, c4 = lane & 7, kr = lane >> 3; const bool nv = n0 + 4 * c4 < N;
#pragma unroll
    for (int j = 0; j < 8; ++j) v[j] = nv ? *(const f32x4*)(W + (size_t)(k0 + 8 * j + kr) * N + n0 + 4 * c4) : (f32x4){0.f, 0.f, 0.f, 0.f};
}
DI int pk4_f8(float a, float b, float c, float d, float sc) { int w = 0; w = __builtin_amdgcn_cvt_pk_fp8_f32(__builtin_amdgcn_fmed3f(a * sc, -448.f, 448.f), __builtin_amdgcn_fmed3f(b * sc, -448.f, 448.f), w, false);
    return __builtin_amdgcn_cvt_pk_fp8_f32(__builtin_amdgcn_fmed3f(c * sc, -448.f, 448.f), __builtin_amdgcn_fmed3f(d * sc, -448.f, 448.f), w, true); }
template <bool F8 = false>
DI void conv_finish(const f32x4 (&v)[8], int N, bf16* WT, int ldk, int kofs, int mode, int row_off, LAS float* scr, int item, int lane, float f8sc = 1.f) {
    const int nblk = (N + 31) / 32, kb = item / nblk, nb = item % nblk, k0 = 64 * kb, n0 = 32 * nb;
    { const int c4 = lane & 7, kr = lane >> 3;
#pragma unroll
      for (int j = 0; j < 8; ++j) { LAS float* d = scr + (8 * j + kr) * 33 + 4 * c4; d[0] = v[j][0]; d[1] = v[j][1]; d[2] = v[j][2]; d[3] = v[j][3]; } }
    LDS_WAIT(); asm volatile("" ::: "memory");
    const int c = lane & 7;
#pragma unroll
    for (int j = 0; j < 4; ++j) { const int n = (lane >> 3) + 8 * j; const LAS float* s = scr + (8 * c) * 33 + n;
        if constexpr (F8) { const uint2 o = make_uint2((unsigned)pk4_f8(s[0 * 33], s[1 * 33], s[2 * 33], s[3 * 33], f8sc), (unsigned)pk4_f8(s[4 * 33], s[5 * 33], s[6 * 33], s[7 * 33], f8sc));
            if (n0 + n < N) *(uint2*)((unsigned char*)WT + (size_t)conv_rowmap(mode, row_off, n0 + n) * ldk + kofs + k0 + 8 * c) = o; }
        else { const v4u o = {pk2(s[0 * 33] * f8sc, s[1 * 33] * f8sc), pk2(s[2 * 33] * f8sc, s[3 * 33] * f8sc), pk2(s[4 * 33] * f8sc, s[5 * 33] * f8sc), pk2(s[6 * 33] * f8sc, s[7 * 33] * f8sc)};
            if (n0 + n < N) *(GAS v4u*)(WT + (size_t)conv_rowmap(mode, row_off, n0 + n) * ldk + kofs + k0 + 8 * c) = o; } }
    LDS_WAIT(); asm volatile("" ::: "memory");
}
DI void conv_job(const float* W, int K, int N, bf16* WT, int ldk, int kofs, int mode, int row_off, LAS float* scr, int gw, int ngw, int lane) {
    const int nitems = (K / 64) * ((N + 31) / 32);
    f32x4 va[8], vb[8];
    int it = gw; if (it < nitems) conv_load(W, N, it, lane, va);
    while (it < nitems) {
        const int i1 = it + ngw; if (i1 < nitems) conv_load(W, N, i1, lane, vb);
        conv_finish(va, N, WT, ldk, kofs, mode, row_off, scr, it, lane);
        if (i1 >= nitems) break;
        const int i2 = i1 + ngw; if (i2 < nitems) conv_load(W, N, i2, lane, va);
        conv_finish(vb, N, WT, ldk, kofs, mode, row_off, scr, i1, lane);
        it = i2;
    }
}

DI void conv_scale_rows(f32x4 (&v)[8], int item, int lane, const float* ga, const float* gb, const float* gc) {
    const int kb = item / 32, k0 = 64 * kb, kr = lane >> 3; const float* g = k0 < 256 ? ga + k0 : k0 < 512 ? gb + (k0 - 256) : gc + (k0 - 512);
#pragma unroll
    for (int j = 0; j < 8; ++j) v[j] *= g[8 * j + kr];
}
DI void conv_job_wo(const float* W, bf16* WT, const float* ga, const float* gb, const float* gc, LAS float* scr, int gw, int ngw, int lane) {
    const int nitems = 16 * 32;
    f32x4 va[8], vb[8];
    int it = gw; if (it < nitems) conv_load(W, 1024, it, lane, va);
    while (it < nitems) {
        const int i1 = it + ngw; if (i1 < nitems) conv_load(W, 1024, i1, lane, vb);
        conv_scale_rows(va, it, lane, ga, gb, gc); conv_finish(va, 1024, WT, 1024, 0, 0, 0, scr, it, lane);
        if (i1 >= nitems) break;
        const int i2 = i1 + ngw; if (i2 < nitems) conv_load(W, 1024, i2, lane, va);
        conv_scale_rows(vb, i1, lane, ga, gb, gc); conv_finish(vb, 1024, WT, 1024, 0, 0, 0, scr, i1, lane);
        it = i2;
    }
}
struct OneUnit { pg8::Unit u; DI bool next(int i, pg8::Unit& o) const { if (i > 0) return false; o.pm = __builtin_amdgcn_readfirstlane(u.pm); o.pn = __builtin_amdgcn_readfirstlane(u.pn); o.aoff = 0; o.boff = 0; return true; } DI void a_ready(const pg8::Unit&) const {} DI void done(const pg8::Unit&) const {} };

template <bool F8 = false>
DI void conv_range(const float* W, size_t wstride, int K, int N, bf16* WT, int ldk, int mode, int row_off0, int jshift, int rstride, int rsub, LAS float* scr, int it0, int step, int end, int lane, float f8sc = 1.f) {
    const int per = (K / 64) * ((N + 31) / 32), jmask = (1 << jshift) - 1;
    f32x4 va[8], vb[8];
    int it = it0; if (it < end) { const int j = it / per; conv_load(W + (size_t)j * wstride, N, it - j * per, lane, va); }
    while (it < end) {
        const int i1 = it + step; if (i1 < end) { const int j = i1 / per; conv_load(W + (size_t)j * wstride, N, i1 - j * per, lane, vb); }
        { const int j = it / per; conv_finish<F8>(va, N, WT, ldk, 0, mode, row_off0 + (j >> jshift) * rstride + (j & jmask) * rsub, scr, it - j * per, lane, f8sc); }
        if (i1 >= end) break;
        const int i2 = i1 + step; if (i2 < end) { const int j = i2 / per; conv_load(W + (size_t)j * wstride, N, i2 - j * per, lane, va); }
        { const int j = i1 / per; conv_finish<F8>(vb, N, WT, ldk, 0, mode, row_off0 + (j >> jshift) * rstride + (j & jmask) * rsub, scr, i1 - j * per, lane, f8sc); }
        it = i2;
    }
}
template <bool F8 = false>
DI void conv_four(const float* W, size_t wstride, int K, int N, bf16* WT, int ldk, int mode, int row_off0, int jshift, int rstride, int rsub, LAS float* scr, int it0, int step, int lane, float f8sc = 1.f) {
    const int per = (K / 64) * ((N + 31) / 32), jmask = (1 << jshift) - 1;
    f32x4 v0[8], v1[8], v2[8], v3[8];
    const int i0 = it0, i1 = it0 + step, i2 = it0 + 2 * step, i3 = it0 + 3 * step; const int j0 = i0 / per, j1 = i1 / per, j2 = i2 / per, j3 = i3 / per;
    conv_load(W + (size_t)j0 * wstride, N, i0 - j0 * per, lane, v0); conv_load(W + (size_t)j1 * wstride, N, i1 - j1 * per, lane, v1);
    conv_load(W + (size_t)j2 * wstride, N, i2 - j2 * per, lane, v2); conv_load(W + (size_t)j3 * wstride, N, i3 - j3 * per, lane, v3);
    conv_finish<F8>(v0, N, WT, ldk, 0, mode, row_off0 + (j0 >> jshift) * rstride + (j0 & jmask) * rsub, scr, i0 - j0 * per, lane, f8sc);
    conv_finish<F8>(v1, N, WT, ldk, 0, mode, row_off0 + (j1 >> jshift) * rstride + (j1 & jmask) * rsub, scr, i1 - j1 * per, lane, f8sc);
    conv_finish<F8>(v2, N, WT, ldk, 0, mode, row_off0 + (j2 >> jshift) * rstride + (j2 & jmask) * rsub, scr, i2 - j2 * per, lane, f8sc);
    conv_finish<F8>(v3, N, WT, ldk, 0, mode, row_off0 + (j3 >> jshift) * rstride + (j3 & jmask) * rsub, scr, i3 - j3 * per, lane, f8sc);
}
template <bool F8 = false>
DI void conv_multi(const float* W, size_t wstride, int njobs, int K, int N, bf16* WT, int ldk, int mode, int row_off0, int jshift, int rstride, int rsub, LAS float* scr, int gw, int ngw, int lane, float f8sc = 1.f) {
    conv_range<F8>(W, wstride, K, N, WT, ldk, mode, row_off0, jshift, rstride, rsub, scr, gw, ngw, (K / 64) * ((N + 31) / 32) * njobs, lane, f8sc);
}

DI void zero_rect(bf16* base, int ld, int row0, int nrows, int col0, int ncols, int gw, int ngw, int lane) {
    const v4u z = {0u, 0u, 0u, 0u};
    for (int r = gw; r < nrows; r += ngw) { v4u* p = (v4u*)(base + (size_t)(row0 + r) * ld + col0); for (int c = lane; c < ncols / 8; c += 64) p[c] = z; }
}
DI void store_bf16_row(bf16* orow, int lane, const f32x4 (&y)[4]) {
#pragma unroll
    for (int j = 0; j < 4; ++j) ((uint2*)orow)[lane + 64 * j] = make_uint2(pk2(y[j][0], y[j][1]), pk2(y[j][2], y[j][3]));
}
DI float ssq4(const f32x4 (&v)[4], int lane) { float s = 0.f;
#pragma unroll
    for (int j = 0; j < 4; ++j) s += (v[j][0] * v[j][0] + v[j][1] * v[j][1]) + (v[j][2] * v[j][2] + v[j][3] * v[j][3]);
    return wave_sum(s, lane); }
DI void xn_row(const float* xrow, const float* g, bf16* orow, int lane) {
    f32x4 v[4];
#pragma unroll
    for (int j = 0; j < 4; ++j) v[j] = ((const f32x4*)xrow)[lane + 64 * j];
    const float r = 1.0f / sqrtf(ssq4(v, lane) * (1.0f / DM) + EPS);
#pragma unroll
    for (int j = 0; j < 4; ++j) v[j] = v[j] * r * ((const f32x4*)g)[lane + 64 * j];
    store_bf16_row(orow, lane, v);
}
DI void xn_row2(const float* x0, const float* x1, const float* g, bf16* o0, bf16* o1, int lane) {
    f32x4 v[4], w[4];
#pragma unroll
    for (int j = 0; j < 4; ++j) { v[j] = ((const f32x4*)x0)[lane + 64 * j]; w[j] = ((const f32x4*)x1)[lane + 64 * j]; }
    const float r0 = 1.0f / sqrtf(ssq4(v, lane) * (1.0f / DM) + EPS), r1 = 1.0f / sqrtf(ssq4(w, lane) * (1.0f / DM) + EPS);
#pragma unroll
    for (int j = 0; j < 4; ++j) { const f32x4 gg = ((const f32x4*)g)[lane + 64 * j]; v[j] = v[j] * r0 * gg; w[j] = w[j] * r1 * gg; }
    store_bf16_row(o0, lane, v); if (o1 != o0) store_bf16_row(o1, lane, w);
}
DI void add_post(f32x4 (&xv)[4], const uint2 (&w)[4], const float* gpost, int lane) {
    f32x4 mp[4];
#pragma unroll
    for (int j = 0; j < 4; ++j) mp[j] = (f32x4){bflo(w[j].x), bfhi(w[j].x), bflo(w[j].y), bfhi(w[j].y)};
    const float r = 1.0f / sqrtf(ssq4(mp, lane) * (1.0f / DM) + EPS);
#pragma unroll
    for (int j = 0; j < 4; ++j) xv[j] = xv[j] + mp[j] * r * ((const f32x4*)gpost)[lane + 64 * j];
}
DI void resnorm_row(f32x4 (&m)[4], const f32x4 (&xv)[4], const float* gpost, float* xout, const float* gpre, bf16* xn, const float* wr, int t, int* toke, int* tokp, float* tokw, gu32* cnt, int lane, unsigned char* age = nullptr, float* rowwe = nullptr) {
    const float r = 1.0f / sqrtf(ssq4(m, lane) * (1.0f / DM) + EPS);
#pragma unroll
    for (int j = 0; j < 4; ++j) { m[j] = xv[j] + m[j] * r * ((const f32x4*)gpost)[lane + 64 * j]; if (xout) ((f32x4*)xout)[lane + 64 * j] = m[j]; }
    if (gpre) {
        const float r2 = 1.0f / sqrtf(ssq4(m, lane) * (1.0f / DM) + EPS);
#pragma unroll
        for (int j = 0; j < 4; ++j) m[j] = m[j] * r2 * ((const f32x4*)gpre)[lane + 64 * j];
        if (!age) store_bf16_row(xn, lane, m);
        if (wr) {
            float lg[8];
#pragma unroll
            for (int e = 0; e < 8; ++e) lg[e] = 0.f;
#pragma unroll
            for (int j = 0; j < 4; ++j)
#pragma unroll
                for (int c = 0; c < 4; ++c) { const int k = 4 * (lane + 64 * j) + c; const f32x4 w0 = *(const f32x4*)(wr + k * 8), w1 = *(const f32x4*)(wr + k * 8 + 4); const float x = m[j][c];
                    lg[0] += x * w0[0]; lg[1] += x * w0[1]; lg[2] += x * w0[2]; lg[3] += x * w0[3]; lg[4] += x * w1[0]; lg[5] += x * w1[1]; lg[6] += x * w1[2]; lg[7] += x * w1[3]; }
#pragma unroll
            for (int e = 0; e < 8; ++e) lg[e] = wave_sum(lg[e], lane);
            int i0 = 0; float v0 = lg[0];
#pragma unroll
            for (int e = 1; e < 8; ++e) if (lg[e] > v0) { v0 = lg[e]; i0 = e; }
            int i1 = -1; float v1 = -3.0e38f;
#pragma unroll
            for (int e = 0; e < 8; ++e) if (e != i0 && lg[e] > v1) { v1 = lg[e]; i1 = e; }
            const float e1 = expf(v1 - v0); const float w0 = 1.0f / (1.0f + e1), w1 = e1 / (1.0f + e1);
            int p0 = 0, p1 = 0;
            if (lane == 0) { p0 = (int)__hip_atomic_fetch_add(cnt + 64 * i0, 1u, RLX_AGENT); p1 = (int)__hip_atomic_fetch_add(cnt + 64 * i1, 1u, RLX_AGENT);
                toke[2 * t] = i0; toke[2 * t + 1] = i1; tokp[2 * t] = p0; tokp[2 * t + 1] = p1; tokw[2 * t] = w0; tokw[2 * t + 1] = w1; }
            if (age) { p0 = __builtin_amdgcn_readfirstlane(p0); p1 = __builtin_amdgcn_readfirstlane(p1); const size_t r0 = (size_t)i0 * NT + p0, r1 = (size_t)i1 * NT + p1;
                if (lane == 0) { rowwe[r0] = w0; rowwe[r1] = w1; }
                unsigned* d0 = (unsigned*)(age + r0 * DM); unsigned* d1 = (unsigned*)(age + r1 * DM);
#pragma unroll
                for (int j = 0; j < 4; ++j) { const unsigned w = (unsigned)pk4_f8(m[j][0], m[j][1], m[j][2], m[j][3], (float)(1 << F8_XN)); d0[lane + 64 * j] = w; d1[lane + 64 * j] = w; } }
        }
    }
}

DI void mla_prep_row(const bf16* prow, const float* rope, const float* g_cq, const float* g_ckv, bf16* cq, bf16* kr, int lane) {
    { const uint2 w = *(const uint2*)(prow + O_BCQ + lane * 4); const float a = bflo(w.x), b = bfhi(w.x), c = bflo(w.y), d = bfhi(w.y);
      const float r = 1.0f / sqrtf(wave_sum(a * a + b * b + c * c + d * d, lane) * (1.0f / 256) + EPS); const f32x4 g = *(const f32x4*)(g_cq + lane * 4);
      *(uint2*)(cq + lane * 4) = make_uint2(pk2(a * r * g[0], b * r * g[1]), pk2(c * r * g[2], d * r * g[3])); }
    { const unsigned w = *(const unsigned*)(prow + O_BCKV + lane * 2); const float a = bflo(w), b = bfhi(w);
      const float r = 1.0f / sqrtf(wave_sum(a * a + b * b, lane) * (1.0f / 128) + EPS); *(unsigned*)(cq + 256 + lane * 2) = pk2(a * r * g_ckv[lane * 2], b * r * g_ckv[lane * 2 + 1]); }
    if (lane < 16) { const float c = rope[lane], s = rope[16 + lane]; const float x1 = bf1(prow[O_BKR + lane]), x2 = bf1(prow[O_BKR + 16 + lane]);
        kr[lane] = (bf16)f2bf(x1 * c - x2 * s); kr[16 + lane] = (bf16)f2bf(x2 * c + x1 * s); }
}
struct CompressOrder {
    int G, c;
    DI bool next(int i, pg8::Unit& u) const { const int L = i * G + c; if (L >= 64) return false; const int mt = L & 15, s = L >> 4, b = mt >> 2, which = (mt >> 1) & 1, g = mt & 1;
        u.pm = s * 16 + mt; u.pn = 0; u.aoff = ((long)b * SQ * NINP + (which ? O_CVC : O_CKC) + g * 64 + (long)s * 8 * NINP) * 2; u.boff = ((long)which * 256 * 2048 + s * 512) * 2; return true; }
    DI void a_ready(const pg8::Unit&) const {}
    DI void done(const pg8::Unit&) const {}
};
DI void compress_finish_item(const float* hidp, const float* cb, const float* w2, bf16* out, int b, int g, int which, int n, LAS float* hb, int lane) {
    const int mt = b * 4 + which * 2 + g; float a0 = cb[lane], a1 = cb[64 + lane];
#pragma unroll
    for (int s = 0; s < 4; ++s) { const float* p = hidp + ((size_t)(s * 16 + mt) * 256 + n) * 128; a0 += p[lane]; a1 += p[64 + lane]; }
    { const float u0 = 0.7978845608028654f * (a0 + 0.044715f * a0 * a0 * a0), u1 = 0.7978845608028654f * (a1 + 0.044715f * a1 * a1 * a1);
      hb[lane] = 0.5f * a0 * (1.0f + tanhf(u0)); hb[64 + lane] = 0.5f * a1 * (1.0f + tanhf(u1)); }
    LDS_WAIT(); asm volatile("" ::: "memory");
    float o = 0.f;
#pragma unroll 8
    for (int e = 0; e < 128; ++e) o += hb[e] * w2[e * 64 + lane];
    out[((size_t)(b * 2 + g) * 256 + n) * 64 + lane] = (bf16)f2bf(o);
    LDS_WAIT(); asm volatile("" ::: "memory");
}

DI void mix_row(const bf16* oa, const bf16* ob, const bf16* oc, const float* g_oa, const float* g_ob, const float* g_oc, bf16* mo, int lane) {
    { const uint2 w = *(const uint2*)(oa + lane * 4); const float a = bflo(w.x), b = bfhi(w.x), c = bflo(w.y), d = bfhi(w.y);
      const float r = 1.0f / sqrtf(wave_sum(a * a + b * b + c * c + d * d, lane) * (1.0f / 256) + EPS); const f32x4 g = *(const f32x4*)(g_oa + lane * 4);
      *(uint2*)(mo + lane * 4) = make_uint2(pk2(a * r * g[0], b * r * g[1]), pk2(c * r * g[2], d * r * g[3])); }
    { const uint2 w = *(const uint2*)(ob + lane * 4); const float a = bflo(w.x), b = bfhi(w.x), c = bflo(w.y), d = bfhi(w.y);
      const float r = 1.0f / sqrtf(wave_sum(a * a + b * b + c * c + d * d, lane) * (1.0f / 256) + EPS); const f32x4 g = *(const f32x4*)(g_ob + lane * 4);
      *(uint2*)(mo + 256 + lane * 4) = make_uint2(pk2(a * r * g[0], b * r * g[1]), pk2(c * r * g[2], d * r * g[3])); }
    { const v4u w = *(const v4u*)(oc + lane * 8); const float x[8] = {bflo(w.x), bfhi(w.x), bflo(w.y), bfhi(w.y), bflo(w.z), bfhi(w.z), bflo(w.w), bfhi(w.w)}; float s = 0.f;
#pragma unroll
      for (int i = 0; i < 8; ++i) s += x[i] * x[i];
      const float r = 1.0f / sqrtf(wave_sum(s, lane) * (1.0f / 512) + EPS); const f32x4 g0 = *(const f32x4*)(g_oc + lane * 8), g1 = *(const f32x4*)(g_oc + lane * 8 + 4);
      const v4u ov = {pk2(x[0] * r * g0[0], x[1] * r * g0[1]), pk2(x[2] * r * g0[2], x[3] * r * g0[3]), pk2(x[4] * r * g1[0], x[5] * r * g1[1]), pk2(x[6] * r * g1[2], x[7] * r * g1[3])};
      *(v4u*)(mo + 512 + lane * 8) = ov; }
}

struct TailColOrder {
    int G, c;
    DI bool next(int i, pg8::Unit& u) const { if (i > 0 || c < 64 || c >= 128) return false; u.pm = c - 64; u.pn = 8; u.aoff = 0; u.boff = 0; return true; }
    DI void a_ready(const pg8::Unit&) const {}
    DI void done(const pg8::Unit&) const {}
};
struct MoeOrder {
    int nN, G, c; const LAS int* tab; int cap; int ae = 0;
    DI bool next(int i, pg8::Unit& u) const { int nt = tab[16]; if (cap && nt > cap) nt = cap; int pm, n;
        if ((G & 7) == 0 && (nN == 4 || nN == 28)) { const int x = c & 7, Lx = i * (G >> 3) + (c >> 3);
            if (nN == 4) { const int cntp = (nt - x + 7) >> 3; if (Lx >= cntp * 4) return false; pm = x + 8 * (Lx >> 2); n = Lx & 3; }
            else { const int a = x & 1, bq = x >> 1, cntp = (nt - a + 1) >> 1; if (Lx >= cntp * 7) return false; const int pl = Lx / 7; pm = a + 2 * pl; n = 7 * bq + (Lx - 7 * pl); } }
        else { const int L = i * G + c; if (L >= nt * nN) return false; pm = L / nN; n = L - pm * nN; }
        const int e = tab[32 + pm]; u.pm = pm; u.pn = e * nN + n; u.aoff = 0; u.boff = 0;
        if (ae) { u.aoff = ((long)e * NT + (long)(pm * 256 - tab[e])) * 1024; u.boff = (long)u.pn * 256 * 1024; }
        return true; }
    DI void a_ready(const pg8::Unit&) const {}
    DI void done(const pg8::Unit&) const {}
};
struct MoeTailOrder {
    int G, c; const LAS int* tab;
    DI bool next(int i, pg8::Unit& u) const { const int L = i * G + c; const int P = tab[16] - 128; if (L >= P * 28) return false; const int pt = L / 28, r = L - pt * 28, n = r / 7, s = r - n * 7, pm = 128 + pt, e = tab[32 + pm];
        u.pm = pm | (s << 16); u.pn = n; u.aoff = (long)pm * 256 * DFE + s * 512; u.boff = ((long)e * 1024 + n * 256) * DFE + s * 512; return true; }
    DI void a_ready(const pg8::Unit&) const {}
    DI void done(const pg8::Unit&) const {}
};
DI f32x4 pair_vals(const bf16* PAIR, const bf16* PART, int r, int q) {
    if (r < 128 * 256) { const int w = ((const int*)((const unsigned char*)PAIR + (size_t)r * DM))[q];
        typedef float f2_ __attribute__((ext_vector_type(2))); const f2_ lo = __builtin_amdgcn_cvt_pk_f32_fp8(w, false), hi = __builtin_amdgcn_cvt_pk_f32_fp8(w, true); const float is = 1.0f / (float)(1 << F8_PAIR);
        return (f32x4){lo[0] * is, lo[1] * is, hi[0] * is, hi[1] * is}; }
    f32x4 a = {0.f, 0.f, 0.f, 0.f};
#pragma unroll
    for (int s = 0; s < 7; ++s) { const uint2 w = ((const uint2*)(PART + ((size_t)s * 8 * 256 + (r - 128 * 256)) * DM))[q]; a += (f32x4){bflo(w.x), bfhi(w.x), bflo(w.y), bfhi(w.y)}; }
    return a;
}
DI void moe_table(gu32* cnt, LAS int* tab, int tid) {
    if (tid == 0) { int o = 0, tix = 0;
        for (int e = 0; e < NEXP; ++e) { const int c = (int)__hip_atomic_load(cnt + 64 * e, RLX_AGENT); tab[e] = o; tab[20 + e] = c; const int nt = (c + 255) >> 8; for (int i = 0; i < nt; ++i) tab[32 + tix++] = e; o += nt * 256; }
        tab[8] = o; tab[16] = tix; }
    __syncthreads();
}

namespace fa {
typedef float f32x16 __attribute__((ext_vector_type(16)));
typedef unsigned u32x2 __attribute__((ext_vector_type(2)));
constexpr int VP = 136, MERGE_OFF = 88064, BLIST_OFF = 122880;
constexpr float NEG = -1e30f;
#define FA_BAR() asm volatile("s_waitcnt lgkmcnt(0)\n\ts_barrier" ::: "memory")
struct Src { const bf16* k1; int k1p; const bf16* k2; const bf16* v; int vp; };
DI int crow(int i, int h) { return (i & 3) + 8 * (i >> 2) + 4 * h; }
DI f32x16 mfma32(bf16x8 a, bf16x8 b, f32x16 c) { return __builtin_amdgcn_mfma_f32_32x32x16_bf16(a, b, c, 0, 0, 0); }
typedef float f32x2v __attribute__((ext_vector_type(2))); typedef __bf16 bf16x2v __attribute__((ext_vector_type(2)));
DI unsigned cvtpk(float lo, float hi) { const f32x2v v = {lo, hi}; return __builtin_bit_cast(unsigned, __builtin_convertvector(v, bf16x2v)); }
DI unsigned pkw(unsigned lo16, unsigned hi16, bool hi) { return hi ? ((lo16 >> 16) | (hi16 & 0xffff0000u)) : ((lo16 & 0xffffu) | (hi16 << 16)); }

template <int DQK, bool SEL, bool BIAS>
DI void unit(LAS unsigned char* L, const Src src, const bf16* qrow, const float* roperow, int tq, float slope2, float m_init, float l_init, unsigned long long selmask, int W, float qscale, int tid, float (&o)[32], const bf16x8* qpre = nullptr, int seq_first = -1, int seq_n = 0) {
    constexpr int KP = DQK == 64 ? 144 : 208, CH = DQK / 8, KHALF = 64 * KP, VHALF = 64 * VP, STAGE = 2 * (KHALF + VHALF), NKL = CH * 64 / 256;
    const int lane = tid & 63, wave = __builtin_amdgcn_readfirstlane(tid >> 6), rs = wave & 3, kh = wave >> 2, r32 = lane & 31, h = lane >> 5, gt = tid & 255;
    const LAS int* blist = (const LAS int*)(L + BLIST_OFF);
    v4u kreg[NKL], vreg[2];
    const int vkp = gt >> 3, vdc = gt & 7;
#define FA_ISSUE_AT(valid_, key0e_) do { if (valid_) { const int key0_ = (key0e_); \
        _Pragma("unroll") for (int i_ = 0; i_ < NKL; ++i_) { const int c_ = gt + 256 * i_, key_ = c_ / CH, ch_ = c_ - key_ * CH; \
            const bf16* sp_ = (DQK == 64 || ch_ < 8) ? src.k1 + (size_t)(key0_ + key_) * src.k1p + 8 * ch_ : src.k2 + (size_t)(key0_ + key_) * 32 + 8 * (ch_ - 8); kreg[i_] = *(const v4u*)sp_; } \
        vreg[0] = *(const v4u*)(src.v + (size_t)(key0_ + 2 * vkp) * src.vp + 8 * vdc); vreg[1] = *(const v4u*)(src.v + (size_t)(key0_ + 2 * vkp + 1) * src.vp + 8 * vdc); } } while (0)
    if (seq_first >= 0) FA_ISSUE_AT(kh < seq_n, 64 * (seq_first + kh));
    bf16x8 qf[DQK / 16];
    if (qpre) {
#pragma unroll
        for (int d0 = 0; d0 < DQK / 16; ++d0) qf[d0] = qpre[d0];
    } else {
        float qv[DQK / 16][8];
#pragma unroll
        for (int d0 = 0; d0 < DQK / 16; ++d0) { const v4u w = *(const v4u*)(qrow + 16 * d0 + 8 * h);
            qv[d0][0] = bflo(w.x); qv[d0][1] = bfhi(w.x); qv[d0][2] = bflo(w.y); qv[d0][3] = bfhi(w.y); qv[d0][4] = bflo(w.z); qv[d0][5] = bfhi(w.z); qv[d0][6] = bflo(w.w); qv[d0][7] = bfhi(w.w); }
        if (DQK > 64) {
#pragma unroll
            for (int j = 0; j < 8; ++j) { const float c = roperow[8 * h + j], s = roperow[16 + 8 * h + j]; const float x1 = qv[4][j], x2 = qv[5][j]; qv[4][j] = x1 * c - x2 * s; qv[5][j] = x2 * c + x1 * s; }
        }
#pragma unroll
        for (int d0 = 0; d0 < DQK / 16; ++d0) { const v4u w = {cvtpk(qv[d0][0] * qscale, qv[d0][1] * qscale), cvtpk(qv[d0][2] * qscale, qv[d0][3] * qscale), cvtpk(qv[d0][4] * qscale, qv[d0][5] * qscale), cvtpk(qv[d0][6] * qscale, qv[d0][7] * qscale)};
            qf[d0] = __builtin_bit_cast(bf16x8, w); }
    }
    f32x16 O0, O1;
#pragma unroll
    for (int i = 0; i < 16; ++i) { O0[i] = 0.f; O1[i] = 0.f; }
    float m = m_init, l = l_init;
    FA_BAR();
    const int nblk = blist[0], nsteps = (nblk + 1) >> 1;
#define FA_ISSUE(step_) do { const int bi_ = 2 * (step_) + kh; FA_ISSUE_AT(bi_ < nblk, 64 * blist[1 + bi_]); } while (0)
#define FA_STORE(step_, stage_) do { const int bi_ = 2 * (step_) + kh; if (bi_ < nblk) { LAS unsigned char* kb_ = L + (stage_) * STAGE + kh * KHALF; LAS unsigned char* vb_ = L + (stage_) * STAGE + 2 * KHALF + kh * VHALF; \
        _Pragma("unroll") for (int i_ = 0; i_ < NKL; ++i_) { const int c_ = gt + 256 * i_, key_ = c_ / CH, ch_ = c_ - key_ * CH; *(LAS v4u*)(kb_ + key_ * KP + ch_ * 16) = kreg[i_]; } \
        LAS unsigned char* vw_ = vb_ + (8 * vdc) * VP + 4 * vkp; \
        *(LAS unsigned*)(vw_ + 0 * VP) = pkw(vreg[0].x, vreg[1].x, false); *(LAS unsigned*)(vw_ + 1 * VP) = pkw(vreg[0].x, vreg[1].x, true); \
        *(LAS unsigned*)(vw_ + 2 * VP) = pkw(vreg[0].y, vreg[1].y, false); *(LAS unsigned*)(vw_ + 3 * VP) = pkw(vreg[0].y, vreg[1].y, true); \
        *(LAS unsigned*)(vw_ + 4 * VP) = pkw(vreg[0].z, vreg[1].z, false); *(LAS unsigned*)(vw_ + 5 * VP) = pkw(vreg[0].z, vreg[1].z, true); \
        *(LAS unsigned*)(vw_ + 6 * VP) = pkw(vreg[0].w, vreg[1].w, false); *(LAS unsigned*)(vw_ + 7 * VP) = pkw(vreg[0].w, vreg[1].w, true); } } while (0)
    if (nsteps > 0) { if (seq_first < 0) FA_ISSUE(0); FA_STORE(0, 0); }
    asm volatile(".p2align 7");
    for (int step = 0; step < nsteps; ++step) {
        const int stage = step & 1;
        if (step + 1 < nsteps) FA_ISSUE(step + 1);
        FA_BAR();
        const int bi = 2 * step + kh;
        if (bi < nblk) {
            const int kb = blist[1 + bi];
            const LAS unsigned char* Kb = L + stage * STAGE + kh * KHALF; const LAS unsigned char* Vb = L + stage * STAGE + 2 * KHALF + kh * VHALF;
            f32x16 X0, X1;
#pragma unroll
            for (int i = 0; i < 16; ++i) { X0[i] = 0.f; X1[i] = 0.f; }
#pragma unroll
            for (int d0 = 0; d0 < DQK / 16; ++d0) { const bf16x8 a0 = *(const LAS bf16x8*)(Kb + r32 * KP + (16 * d0 + 8 * h) * 2), a1 = *(const LAS bf16x8*)(Kb + (32 + r32) * KP + (16 * d0 + 8 * h) * 2);
                X0 = mfma32(a0, qf[d0], X0); X1 = mfma32(a1, qf[d0], X1); }
            const int db = tq - 64 * kb - 4 * h; bool rowok = true; if (SEL) rowok = (selmask >> kb) & 1ull;
            const int tqlo = __builtin_amdgcn_readfirstlane(tq);
            const bool interior = (64 * kb + 63 <= tqlo) && (tqlo + 31 - 64 * kb < W);
            const float base = BIAS ? -slope2 * (float)db : 0.f;
            float mx = NEG;
            if (interior) {
#pragma unroll
                for (int i = 0; i < 16; ++i) { const float cf = (float)((i & 3) + 8 * (i >> 2));
                    if (BIAS) { X0[i] = fmaf(slope2, cf, X0[i]); X1[i] = fmaf(slope2, cf + 32.f, X1[i]); }
                    mx = fmaxf(mx, fmaxf(X0[i], X1[i])); }
            } else {
#pragma unroll
                for (int i = 0; i < 16; ++i) { const int c0 = (i & 3) + 8 * (i >> 2);
                    { const int d = db - c0; const float x = BIAS ? fmaf(slope2, (float)c0, X0[i]) : X0[i]; const bool ok = (unsigned)d < (unsigned)W; X0[i] = ok ? x : NEG; }
                    { const int d = db - c0 - 32; const float x = BIAS ? fmaf(slope2, (float)(c0 + 32), X1[i]) : X1[i]; const bool ok = (unsigned)d < (unsigned)W; X1[i] = ok ? x : NEG; }
                    mx = fmaxf(mx, fmaxf(X0[i], X1[i])); }
            }
            mx = mx + base; if (SEL) mx = rowok ? mx : NEG;
            if (__builtin_amdgcn_ballot_w64(mx > m + 8.0f)) { mx = fmaxf(mx, shx(mx, 32, lane)); const float mnew = fmaxf(m, mx); const float alpha = __builtin_amdgcn_exp2f(m - mnew); l *= alpha; m = mnew;
#pragma unroll
                for (int i = 0; i < 16; ++i) { O0[i] *= alpha; O1[i] *= alpha; } }
            float mref = m - base; if (SEL) mref = rowok ? mref : 1e30f;
            float ls = 0.f;
#pragma unroll
            for (int i = 0; i < 16; ++i) { X0[i] = __builtin_amdgcn_exp2f(X0[i] - mref); X1[i] = __builtin_amdgcn_exp2f(X1[i] - mref); ls += X0[i] + X1[i]; }
            l += ls;
#pragma unroll
            for (int kt = 0; kt < 2; ++kt)
#pragma unroll
                for (int s = 0; s < 2; ++s) {
                    const f32x16& X = kt ? X1 : X0;
                    const v4u pw = {cvtpk(X[8 * s + 0], X[8 * s + 1]), cvtpk(X[8 * s + 2], X[8 * s + 3]), cvtpk(X[8 * s + 4], X[8 * s + 5]), cvtpk(X[8 * s + 6], X[8 * s + 7])};
                    const bf16x8 pf = __builtin_bit_cast(bf16x8, pw);
                    const int kofs = (32 * kt + 16 * s + 4 * h) * 2;
                    { const u32x2 lo = *(const LAS u32x2*)(Vb + r32 * VP + kofs), hi = *(const LAS u32x2*)(Vb + r32 * VP + kofs + 16); const v4u vw = {lo.x, lo.y, hi.x, hi.y};
                      O0 = mfma32(__builtin_bit_cast(bf16x8, vw), pf, O0); }
                    { const u32x2 lo = *(const LAS u32x2*)(Vb + (32 + r32) * VP + kofs), hi = *(const LAS u32x2*)(Vb + (32 + r32) * VP + kofs + 16); const v4u vw = {lo.x, lo.y, hi.x, hi.y};
                      O1 = mfma32(__builtin_bit_cast(bf16x8, vw), pf, O1); }
                }
        }
        if (step + 1 < nsteps) FA_STORE(step + 1, stage ^ 1);
    }
#undef FA_ISSUE
#undef FA_ISSUE_AT
#undef FA_STORE
    l += shx(l, 32, lane);
    LAS float* mg = (LAS float*)(L + MERGE_OFF) + rs * 64 + lane;
    if (kh == 1) { mg[0] = m; mg[256] = l;
#pragma unroll
        for (int i = 0; i < 16; ++i) { mg[(2 + i) * 256] = O0[i]; mg[(18 + i) * 256] = O1[i]; } }
    FA_BAR();
    if (kh == 0) { const float m2 = mg[0], l2 = mg[256]; const float mf = fmaxf(m, m2), a1 = __builtin_amdgcn_exp2f(m - mf), a2 = __builtin_amdgcn_exp2f(m2 - mf);
        const float inv = 1.0f / (l * a1 + l2 * a2);
#pragma unroll
        for (int i = 0; i < 16; ++i) { o[i] = (O0[i] * a1 + mg[(2 + i) * 256] * a2) * inv; o[16 + i] = (O1[i] * a1 + mg[(18 + i) * 256] * a2) * inv; } }
}
DI void make_qf64(const bf16* qrow, int h, float qscale, bf16x8 (&qf)[4]) {
#pragma unroll
    for (int d0 = 0; d0 < 4; ++d0) { const v4u w = *(const v4u*)(qrow + 16 * d0 + 8 * h);
        const v4u ws = {cvtpk(bflo(w.x) * qscale, bfhi(w.x) * qscale), cvtpk(bflo(w.y) * qscale, bfhi(w.y) * qscale), cvtpk(bflo(w.z) * qscale, bfhi(w.z) * qscale), cvtpk(bflo(w.w) * qscale, bfhi(w.w) * qscale)};
        qf[d0] = __builtin_bit_cast(bf16x8, ws); }
}
DI void store_row(bf16* orow, const float (&o)[32], int h) {
    typedef unsigned u2v __attribute__((ext_vector_type(2)));
#pragma unroll
    for (int dblk = 0; dblk < 2; ++dblk)
#pragma unroll
        for (int q = 0; q < 2; ++q) { const int ia = 16 * dblk + 8 * q, ib = ia + 4;
            const unsigned a0 = cvtpk(o[ia], o[ia + 1]), a1 = cvtpk(o[ia + 2], o[ia + 3]), b0 = cvtpk(o[ib], o[ib + 1]), b1 = cvtpk(o[ib + 2], o[ib + 3]);
            const u2v s0 = __builtin_amdgcn_permlane32_swap(a0, b0, false, false), s1 = __builtin_amdgcn_permlane32_swap(a1, b1, false, false);
            const v4u w = {s0[0], s1[0], s0[1], s1[1]};
            *(v4u*)(orow + 32 * dblk + 16 * q + 8 * h) = w; }
}
}
constexpr float LOG2E = 1.4426950408889634f;
DI void store_head(bf16* ocat_row, float* ssq, const float (&o)[32], int h, int lane) {
    fa::store_row(ocat_row, o, h);
    float s = 0.f;
#pragma unroll
    for (int i = 0; i < 32; ++i) s += o[i] * o[i];
    s += shx(s, 32, lane);
    if (h == 0) *ssq = s;
}
DI void fa_write_blist(LAS unsigned char* L, int first, int last, int tid) {
    if (tid < 64) { LAS int* bl = (LAS int*)(L + fa::BLIST_OFF); const int n = last - first + 1; if (tid < n) bl[1 + tid] = first + tid; if (tid == 0) bl[0] = n; }
}
DI void attn_a_unit(LAS unsigned char* L, const bf16* PROJ, const float* sinks, bf16* OCAT, float* SSQ, int b, int g, int c, int tid) {
    const int lane = tid & 63, wave = __builtin_amdgcn_readfirstlane(tid >> 6), rs = wave & 3, kh = wave >> 2, r32 = lane & 31, h = lane >> 5;
    const int r = rs >> 1, t = 64 * c + 32 * (rs & 1) + r32, hq = 2 * g + r;
    fa_write_blist(L, c - 2 > 0 ? c - 2 : 0, c, tid);
    const fa::Src s{PROJ + (size_t)b * SQ * NINP + O_AK + g * 64, NINP, nullptr, PROJ + (size_t)b * SQ * NINP + O_AV + g * 64, NINP};
    float o[32];
    fa::unit<64, false, true>(L, s, PROJ + (size_t)(b * SQ + t) * NINP + O_AQ + hq * 64, nullptr, t, exp2f(-2.0f * (float)(hq + 1)) * LOG2E, sinks[hq] * LOG2E, (kh == 0 && h == 0) ? 1.f : 0.f, 0ull, 128, 0.125f * LOG2E, tid, o, nullptr, c - 2 > 0 ? c - 2 : 0, c - (c - 2 > 0 ? c - 2 : 0) + 1);
    if (kh == 0) store_head(OCAT + (size_t)(b * SQ + t) * 1024 + hq * 64, SSQ + (size_t)(b * SQ + t) * 16 + hq, o, h, lane);
}
DI void attn_b_unit(LAS unsigned char* L, const bf16* QB, const bf16* KVB, const bf16* KR, const float* ROPE, bf16* OCAT, float* SSQ, int b, int hd, int c, int tid) {
    const int lane = tid & 63, wave = __builtin_amdgcn_readfirstlane(tid >> 6), rs = wave & 3, kh = wave >> 2, r32 = lane & 31, h = lane >> 5;
    const int t = 128 * c + 32 * rs + r32;
    fa_write_blist(L, 0, 2 * c + 1, tid);
    const fa::Src s{KVB + (size_t)b * SQ * 512 + hd * 128, 512, KR + (size_t)b * SQ * 32, KVB + (size_t)b * SQ * 512 + hd * 128 + 64, 512};
    float o[32];
    fa::unit<96, false, false>(L, s, QB + (size_t)(b * SQ + t) * 384 + hd * 96, ROPE + (size_t)(b * SQ + t) * 32, t, 0.f, fa::NEG, 0.f, 0ull, 1 << 30, 0.10206207261596575f * LOG2E, tid, o, nullptr, 0, 2 * c + 2);
    if (kh == 0) store_head(OCAT + (size_t)(b * SQ + t) * 1024 + 256 + hd * 64, SSQ + (size_t)(b * SQ + t) * 16 + 4 + hd, o, h, lane);
}
DI int wg_pop(gu32* ctr, LAS int* slot, int tid) {
    __syncthreads();
    if (tid == 0) *slot = (int)__hip_atomic_fetch_add(ctr, 1u, RLX_AGENT);
    __syncthreads();
    return *slot;
}
namespace cmpu {
constexpr int CK = 0, CV = 36864, XMX = 70144, XLS = 71168, XO = 72192, SLAB = 0, IMPF = 104960, KP = 144, VPC = 520, MASK_OFF = RING_BYTES + 640;
DI void unit(LAS unsigned char* L, const bf16* kcb, const bf16* vcb, const bf16* qrow, float qscale, bf16x8 (&qf)[4], int tq, float slope2, int c, int tid, float (&o)[32]) {
    using fa::f32x16; using fa::u32x2; using fa::mfma32; using fa::NEG;
    const int lane = tid & 63, wave = __builtin_amdgcn_readfirstlane(tid >> 6), rs = wave & 3, kh = wave >> 2, r32 = lane & 31, h = lane >> 5;
    const int nv = 2 * c + 1, ntile = (nv + 31) >> 5;
    const int nkc = 32 * ntile * 8, nvt = 16 * ntile * 8;
    v4u kcr[4], v0r[2], v1r[2];
#pragma unroll
    for (int i = 0; i < 4; ++i) { const int ci = tid + 512 * i; if (ci < nkc) kcr[i] = *(const v4u*)(kcb + (ci >> 3) * 64 + (ci & 7) * 8); }
#pragma unroll
    for (int i = 0; i < 2; ++i) { const int tk = tid + 512 * i; if (tk < nvt) { const int kp = tk >> 3, dc = tk & 7; v0r[i] = *(const v4u*)(vcb + (2 * kp) * 64 + 8 * dc); v1r[i] = *(const v4u*)(vcb + (2 * kp + 1) * 64 + 8 * dc); } }
    fa::make_qf64(qrow, h, qscale, qf);
    FA_BAR();
#pragma unroll
    for (int i = 0; i < 4; ++i) { const int ci = tid + 512 * i; if (ci < nkc) *(LAS v4u*)(L + CK + (ci >> 3) * KP + (ci & 7) * 16) = kcr[i]; }
#pragma unroll
    for (int i = 0; i < 2; ++i) { const int tk = tid + 512 * i; if (tk < nvt) { const int kp = tk >> 3, dc = tk & 7; const v4u v0 = v0r[i], v1 = v1r[i];
        LAS unsigned char* vw = L + CV + (8 * dc) * VPC + 4 * kp;
        *(LAS unsigned*)(vw + 0 * VPC) = fa::pkw(v0.x, v1.x, false); *(LAS unsigned*)(vw + 1 * VPC) = fa::pkw(v0.x, v1.x, true); *(LAS unsigned*)(vw + 2 * VPC) = fa::pkw(v0.y, v1.y, false); *(LAS unsigned*)(vw + 3 * VPC) = fa::pkw(v0.y, v1.y, true);
        *(LAS unsigned*)(vw + 4 * VPC) = fa::pkw(v0.z, v1.z, false); *(LAS unsigned*)(vw + 5 * VPC) = fa::pkw(v0.z, v1.z, true); *(LAS unsigned*)(vw + 6 * VPC) = fa::pkw(v0.w, v1.w, false); *(LAS unsigned*)(vw + 7 * VPC) = fa::pkw(v0.w, v1.w, true); } }
    FA_BAR();
    f32x16 X[4]; float mx = NEG;
#pragma unroll
    for (int jt = 0; jt < 4; ++jt) { const int tau = 2 * jt + kh;
#pragma unroll
        for (int i = 0; i < 16; ++i) X[jt][i] = 0.f;
        if (tau < ntile) {
#pragma unroll
            for (int d0 = 0; d0 < 4; ++d0) { const bf16x8 a = *(const LAS bf16x8*)(L + CK + (32 * tau + r32) * KP + (16 * d0 + 8 * h) * 2); X[jt] = mfma32(a, qf[d0], X[jt]); }
            const int db = tq - 31 - 16 * (32 * tau + 4 * h);
#pragma unroll
            for (int i = 0; i < 16; ++i) { const int d = db - 16 * ((i & 3) + 8 * (i >> 2)); const float x = fmaf(-slope2, (float)d, X[jt][i]); X[jt][i] = d >= 0 ? x : NEG; mx = fmaxf(mx, X[jt][i]); }
        } else {
#pragma unroll
            for (int i = 0; i < 16; ++i) X[jt][i] = NEG;
        } }
    mx = fmaxf(mx, shx(mx, 32, lane));
    LAS float* xm = (LAS float*)(L + XMX); LAS float* xl = (LAS float*)(L + XLS);
    if (h == 0) xm[kh * 128 + rs * 32 + r32] = mx;
    FA_BAR();
    const float m = fmaxf(xm[rs * 32 + r32], xm[128 + rs * 32 + r32]);
    float ls = 0.f;
#pragma unroll
    for (int jt = 0; jt < 4; ++jt)
#pragma unroll
        for (int i = 0; i < 16; ++i) { const float x = X[jt][i]; const float p = x > -1e29f ? __builtin_amdgcn_exp2f(x - m) : 0.f; X[jt][i] = p; ls += p; }
    ls += shx(ls, 32, lane);
    if (h == 0) xl[kh * 128 + rs * 32 + r32] = ls;
    FA_BAR();
    const float lt = xl[rs * 32 + r32] + xl[128 + rs * 32 + r32]; const float inv = lt > 0.f ? 1.0f / lt : 0.f;
    const bool need_imp = c >= 32;
    f32x16 O0, O1, I0, I1;
#pragma unroll
    for (int i = 0; i < 16; ++i) { O0[i] = 0.f; O1[i] = 0.f; I0[i] = 0.f; I1[i] = 0.f; }
#pragma unroll
    for (int jt = 0; jt < 4; ++jt) { const int tau = 2 * jt + kh;
        if (tau < ntile) {
#pragma unroll
            for (int s = 0; s < 2; ++s) {
                const v4u pw = {fa::cvtpk(X[jt][8 * s + 0] * inv, X[jt][8 * s + 1] * inv), fa::cvtpk(X[jt][8 * s + 2] * inv, X[jt][8 * s + 3] * inv), fa::cvtpk(X[jt][8 * s + 4] * inv, X[jt][8 * s + 5] * inv), fa::cvtpk(X[jt][8 * s + 6] * inv, X[jt][8 * s + 7] * inv)};
                const bf16x8 pf = __builtin_bit_cast(bf16x8, pw);
                const int kofs = (32 * tau + 16 * s + 4 * h) * 2;
                { const u32x2 lo = *(const LAS u32x2*)(L + CV + r32 * VPC + kofs), hi = *(const LAS u32x2*)(L + CV + r32 * VPC + kofs + 16); const v4u vw = {lo.x, lo.y, hi.x, hi.y}; O0 = mfma32(__builtin_bit_cast(bf16x8, vw), pf, O0); }
                { const u32x2 lo = *(const LAS u32x2*)(L + CV + (32 + r32) * VPC + kofs), hi = *(const LAS u32x2*)(L + CV + (32 + r32) * VPC + kofs + 16); const v4u vw = {lo.x, lo.y, hi.x, hi.y}; O1 = mfma32(__builtin_bit_cast(bf16x8, vw), pf, O1); }
#pragma unroll
                for (int jb = 0; jb < 2; ++jb) { if (!need_imp || (jb != (tau >> 2) && !(tau == 3 && jb == 1))) continue;
                    const int nb = 32 * tau + 16 * s + 4 * h - 4 * (32 * jb + r32); unsigned ww[4];
#pragma unroll
                    for (int q2 = 0; q2 < 4; ++q2) { const int d0 = nb + 8 * (q2 >> 1) + 2 * (q2 & 1), d1 = d0 + 1;
                        const unsigned w0 = (d0 == -1 || d0 == 3) ? 0x3f80u : ((unsigned)d0 <= 2u ? 0x4000u : 0u), w1 = (d1 == -1 || d1 == 3) ? 0x3f80u : ((unsigned)d1 <= 2u ? 0x4000u : 0u); ww[q2] = w0 | (w1 << 16); }
                    const v4u aw = {ww[0], ww[1], ww[2], ww[3]};
                    if (jb == 0) I0 = mfma32(__builtin_bit_cast(bf16x8, aw), pf, I0); else I1 = mfma32(__builtin_bit_cast(bf16x8, aw), pf, I1); }
            } } }
    FA_BAR();
    if (need_imp) { LAS float* sl = (LAS float*)(L + SLAB) + wave * 2048 + r32;
#pragma unroll
      for (int i = 0; i < 16; ++i) { const int j = fa::crow(i, h); sl[j * 32] = I0[i]; sl[(32 + j) * 32] = I1[i]; } }
    LAS float* xo = (LAS float*)(L + XO) + rs * 64 + lane;
    if (kh == 1) {
#pragma unroll
        for (int i = 0; i < 16; ++i) { xo[i * 256] = O0[i]; xo[(16 + i) * 256] = O1[i]; } }
    FA_BAR();
    if (kh == 0) {
#pragma unroll
        for (int i = 0; i < 16; ++i) { o[i] = O0[i] + xo[i * 256]; o[16 + i] = O1[i] + xo[(16 + i) * 256]; } }
    if (need_imp) { const LAS float* sl = (const LAS float*)(L + SLAB); LAS float* imp = (LAS float*)(L + IMPF);
#pragma unroll
      for (int k = 0; k < 4; ++k) { const int e = tid + 512 * k, j = e >> 5, tl = e & 31; float a = 0.f;
#pragma unroll
          for (int w = 0; w < 8; ++w) a += sl[w * 2048 + j * 32 + tl];
          imp[tl * 64 + j] = a; } }
    FA_BAR();
    if (!need_imp) { LAS unsigned long long* mk = (LAS unsigned long long*)(L + MASK_OFF);
      if (tid < 32) { const int t = 32 * c + tid; mk[tid] = (2ull << (t >> 6)) - 1ull; } }
    else { const LAS float* imp = (const LAS float*)(L + IMPF); LAS unsigned long long* mk = (LAS unsigned long long*)(L + MASK_OFF);
#pragma unroll 1
      for (int k = 0; k < 4; ++k) { const int tl = wave + 8 * k, t = 32 * c + tl, j = lane, cur = t >> 6;
          const bool avail = 64 * j <= t, forced = (j == 0) || (j == cur) || (j == cur - 1);
          float val = avail ? imp[tl * 64 + j] : -1e30f; if (forced) val = 1e30f;
          const unsigned fb = __float_as_uint(val), key = (fb & 0x80000000u) ? ~fb : (fb | 0x80000000u);
          unsigned res = 0u;
#pragma unroll
          for (int bit = 31; bit >= 0; --bit) { const unsigned cand = res | (1u << bit); const int cnt = __builtin_popcountll(__builtin_amdgcn_ballot_w64(key >= cand)); if (cnt >= 16) res = cand; }
          const unsigned long long gt = __builtin_amdgcn_ballot_w64(key > res), eq = __builtin_amdgcn_ballot_w64(key == res);
          const int need = 16 - __builtin_popcountll(gt);
          const int before = __builtin_popcountll(eq & ((1ull << j) - 1ull));
          const bool sel = (key > res) || (key == res && before < need);
          const unsigned long long bal = __builtin_amdgcn_ballot_w64(sel && avail);
          if (lane == 0) mk[tl] = bal; } }
    FA_BAR();
}
}

DI void attn_c_unit(LAS unsigned char* L, const bf16* PROJ, const bf16* KCb, const bf16* VCb, bf16* OCAT, float* SSQ, int b, int g, int c, int tid) {
    const int lane = tid & 63, wave = __builtin_amdgcn_readfirstlane(tid >> 6), rs = wave & 3, kh = wave >> 2, r32 = lane & 31, h = lane >> 5;
    const int t = 32 * c + r32, hq = 4 * g + rs; const float slope2 = exp2f(-(float)(hq + 1)) * LOG2E;
    const bf16* prow = PROJ + (size_t)(b * SQ + t) * NINP; const bf16* qrow = prow + O_CQ + hq * 64; const bf16* kvb = PROJ + (size_t)b * SQ * NINP + g * 64;
    float o[32], acc[32];
    bf16x8 qf[4];
    cmpu::unit(L, KCb + (size_t)(b * 2 + g) * 256 * 64, VCb + (size_t)(b * 2 + g) * 256 * 64, qrow, 0.125f * LOG2E, qf, t, slope2, c, tid, o);
    { const float g0 = 1.0f / (1.0f + __expf(-bf1(prow[O_CG + hq * 3 + 0])));
#pragma unroll
      for (int i = 0; i < 32; ++i) acc[i] = g0 * o[i]; }
    { const int lo = 32 * c - 511; fa_write_blist(L, (lo > 0 ? lo : 0) >> 6, (32 * c + 31) >> 6, tid);
      const fa::Src s{kvb + O_CKW, NINP, nullptr, kvb + O_CVW, NINP};
      fa::unit<64, false, true>(L, s, qrow, nullptr, t, slope2, fa::NEG, 0.f, 0ull, 512, 0.125f * LOG2E, tid, o, qf, (lo > 0 ? lo : 0) >> 6, ((32 * c + 31) >> 6) - ((lo > 0 ? lo : 0) >> 6) + 1);
      const float g2 = 1.0f / (1.0f + __expf(-bf1(prow[O_CG + hq * 3 + 2])));
#pragma unroll
      for (int i = 0; i < 32; ++i) acc[i] += g2 * o[i]; }
    { const unsigned long long mk = ((const LAS unsigned long long*)(L + cmpu::MASK_OFF))[r32];
      if (wave == 0) { unsigned lo = (unsigned)mk, hi = (unsigned)(mk >> 32);
#pragma unroll
          for (int x = 16; x > 0; x >>= 1) { lo |= shxu(lo, x, lane); hi |= shxu(hi, x, lane); }
          { LAS int* bl = (LAS int*)(L + fa::BLIST_OFF); const unsigned long long um = ((unsigned long long)hi << 32) | lo;
            if ((um >> lane) & 1ull) bl[1 + __builtin_popcountll(um & ((1ull << lane) - 1ull))] = lane; if (lane == 0) bl[0] = __builtin_popcountll(um); } }
      const fa::Src s{kvb + O_CKS, NINP, nullptr, kvb + O_CVS, NINP};
      fa::unit<64, true, true>(L, s, qrow, nullptr, t, slope2, fa::NEG, 0.f, mk, 1 << 30, 0.125f * LOG2E, tid, o, qf);
      const float g1 = 1.0f / (1.0f + __expf(-bf1(prow[O_CG + hq * 3 + 1])));
#pragma unroll
      for (int i = 0; i < 32; ++i) acc[i] += g1 * o[i]; }
    if (kh == 0) store_head(OCAT + (size_t)(b * SQ + t) * 1024 + 512 + hq * 64, SSQ + (size_t)(b * SQ + t) * 16 + 8 + hq, acc, h, lane);
}

#define BUFS() GAS unsigned char* wsl = (GAS unsigned char*)ws; asm volatile("" : "+s"(wsl)); int tidp_; asm volatile("v_mbcnt_lo_u32_b32 %0, -1, 0\n\tv_mbcnt_hi_u32_b32 %0, -1, %0" : "=v"(tidp_)); tidp_ += wave_s * 64; const int tid = tidp_, lane = tid & 63, wave = __builtin_amdgcn_readfirstlane(tid >> 6), gw = blockIdx.x * NWAVES + wave; (void)tid; (void)lane; (void)gw; \
    bf16 *WIN = (bf16*)(wsl + WS_WIN), *WUP = (bf16*)(wsl + WS_WUP), *WO = (bf16*)(wsl + WS_WO), *WGU = (bf16*)(wsl + WS_WGU), *WD = (bf16*)(wsl + WS_WD); \
    float* ROPE = (float*)(wsl + WS_ROPE); \
    int *TOKE = (int*)(wsl + WS_TOKE), *TOKP = (int*)(wsl + WS_TOKP), *ROWTOK = (int*)(wsl + WS_ROWTOK); float *TOKW = (float*)(wsl + WS_TOKW), *ROWW = (float*)(wsl + WS_ROWW), *ROWWE = (float*)(wsl + WS_ROWWE); (void)ROWW; (void)ROWWE; (void)ROWTOK; float* SSQ0 = (float*)(wsl + WS_SSQ); (void)SSQ0; \
    bf16 *PROJ = (bf16*)(wsl + WS_PROJ), *CQKV = (bf16*)(wsl + WS_CQKV), *QB = (bf16*)(wsl + WS_QB), *KVB = (bf16*)(wsl + WS_KVB), *KR = (bf16*)(wsl + WS_KR), *OA = (bf16*)(wsl + WS_OA), *OB = (bf16*)(wsl + WS_OB), \
         *OCMP = (bf16*)(wsl + WS_OCMP), *OSLC = (bf16*)(wsl + WS_OSLC), *OWIN = (bf16*)(wsl + WS_OWIN), *XN = (bf16*)(wsl + WS_XN), *MIXED = (bf16*)(wsl + WS_MIXED), *HIDB = (bf16*)(wsl + WS_HIDB), \
         *MGU = (bf16*)(wsl + WS_MGU), *AG = (bf16*)(wsl + WS_AG), *HIDM = (bf16*)(wsl + WS_HIDM), *MD = (bf16*)(wsl + WS_MD), *PAIR = (bf16*)(wsl + WS_PAIR), *PART = (bf16*)(wsl + WS_PART); \
    bf16 *WC1 = (bf16*)(wsl + WS_WC1); float *HIDP = (float*)(wsl + WS_HIDP), *CBIAS = (float*)(wsl + WS_CBIAS), *CBPART = (float*)(wsl + WS_CBIAS + 65536); bf16 *KCB = (bf16*)(wsl + WS_KC), *VCB = (bf16*)(wsl + WS_VC), *OC = (bf16*)(wsl + WS_OCMP); bf16 *MOUT = (bf16*)(wsl + WS_MOUT), *FOUT = (bf16*)(wsl + WS_FOUT); \
    unsigned long long* SELM = (unsigned long long*)(wsl + WS_SELM); gu32* ctl = (gu32*)(wsl + WS_CTL); gu32* cnt = ctl + CW_CNT; (void)cnt;
#define WCONV_CHUNK(ch_, wv_, ln_) do { const int ch = (ch_); LAS float* scr = (LAS float*)(L + (wv_) * 16384); \
        if (l == 0 && ch >= NCH_GU) { const int c3 = ch - NCH_GU, m = c3 / (NCH_F / 3), c4 = c3 - m * (NCH_F / 3); \
            if (m < 2) conv_four<false>(INP(22 + m), 0, 1024, 4096, WGU, 1024, 1, m * 128, 0, 0, 0, scr, c4 * CONV_CHUNK + (wv_), NWAVES, (ln_), m ? (float)(1 << F8_HID) * 0.6931471805599453f : 1.4426950408889634f);     \
            else conv_four<true>(INP(24), 0, 4096, 1024, WD, 4096, 0, 0, 0, 0, 0, scr, c4 * CONV_CHUNK + (wv_), NWAVES, (ln_), (float)(1 << F8_WD)); } \
        else if (l == 0) { const int up = ch >= NCH_GU / 2 ? 1 : 0, c2 = ch - up * (NCH_GU / 2); \
            conv_four<true>(INP(26 + up), (size_t)DM * DFE, 1024, DFE, MGU, 1024, 1, up * 128, 0, 2 * DFE, 0, scr, c2 * CONV_CHUNK + (wv_), NWAVES, (ln_), up ? (float)(1 << (F8_WGU + F8_HID)) * 0.6931471805599453f : (float)(1 << F8_WGU) * 1.4426950408889634f); }     \
        else conv_four<true>(INP(28), (size_t)DFE * DM, DFE, 1024, MD, DFE, 0, 0, 0, 1024, 0, scr, ch * CONV_CHUNK + (wv_), NWAVES, (ln_), (float)(1 << F8_WD)); } while (0)
#define KAS __attribute__((address_space(4)))
#define INP(i) ({ const KAS unsigned char* kp_ = (const KAS unsigned char*)__builtin_amdgcn_kernarg_segment_ptr(); asm volatile("" : "+s"(kp_)); (const float*)*(const GAS float* const KAS*)(kp_ + 8 * (i)); })
struct MkArgs { const float* in[29]; float* out; unsigned char* ws; int ph_lo, ph_hi; };
__global__ void __launch_bounds__(NWAVES * 64, 2) mk(MkArgs a) {
    extern __shared__ __attribute__((aligned(16))) unsigned char lds[];
    LAS unsigned char* L = (LAS unsigned char*)lds;
    const int G = gridDim.x, ngw = G * NWAVES, wave_s = __builtin_amdgcn_readfirstlane(threadIdx.x >> 6);
    unsigned char* ws = a.ws;
    for (int u = threadIdx.x; u < (LDS_BYTES - LDSCTL_OFF) / 4; u += NWAVES * 64) ((LAS unsigned*)(L + LDSCTL_OFF))[u] = 0u;
    __syncthreads();
    XcdBarrier bar = xcd_barrier_post((unsigned*)(ws + WS_CTL) + CW_BAR, (volatile LAS unsigned*)(L + MISC_OFF) + 8);
    const int lo = a.ph_lo, hi = a.ph_hi;
#define IN(k) (lo <= (k) && (k) < hi)
#define SEAM(k) do { if (IN(k) && IN((k) + 1)) { XcdBarrier b_ = bar; GAS unsigned* bp_ = (GAS unsigned*)bar.bar; asm volatile("" : "+s"(bp_)); b_.bar = (unsigned*)bp_; xcd_barrier(b_); } } while (0)
    float* xo = a.out;
    LAS int* tab = (LAS int*)(L + TAB_OFF);

    if (IN(PH_PRO)) { BUFS();
        LAS float* scr = (LAS float*)(L + wave * 16384);
        int rot = 0;
#define GWR(n_) ({ int g_ = gw - rot; if (g_ < 0) g_ += ngw; rot = (rot + (n_)) % ngw; g_; })
        for (int l = 0; l < 2; ++l) {
            conv_job(INP(2) + (size_t)l * 1024 * NIN, 1024, NIN, (bf16*)((unsigned char*)WIN + l * WIN_L), 1024, 0, 0, 0, scr, GWR(((1024) / 64) * (((NIN) + 31) / 32)), ngw, lane);
            conv_job(INP(5) + (size_t)l * 256 * 384, 256, 384, (bf16*)((unsigned char*)WUP + l * WUP_L), 384, 0, 0, 0, scr, GWR(((256) / 64) * (((384) + 31) / 32)), ngw, lane);
            conv_job(INP(7) + (size_t)l * 128 * 512, 128, 512, (bf16*)((unsigned char*)WUP + l * WUP_L), 384, 256, 0, 384, scr, GWR(((128) / 64) * (((512) + 31) / 32)), ngw, lane);
            conv_job_wo(INP(17) + (size_t)l * 1024 * 1024, (bf16*)((unsigned char*)WO + l * WO_L), INP(14) + l * 256, INP(15) + l * 256, INP(16) + l * 512, scr, GWR(16 * 32), ngw, lane);
        }
        for (int l = 0; l < 2; ++l) {
            zero_rect((bf16*)((unsigned char*)WIN + l * WIN_L), 1024, NIN, NINP - NIN, 0, 1024, GWR(NINP - NIN), ngw, lane);
            bf16* wu = (bf16*)((unsigned char*)WUP + l * WUP_L);
            zero_rect(wu, 384, 0, 384, 256, 128, GWR(384), ngw, lane); zero_rect(wu, 384, 384, 512, 0, 256, GWR(512), ngw, lane); zero_rect(wu, 384, 896, 128, 0, 384, GWR(128), ngw, lane);
            bf16* wc = (bf16*)((unsigned char*)WC1 + l * WC1_L);
            zero_rect(wc, 2048, 128, 128, 0, 2048, GWR(128), ngw, lane); zero_rect(wc, 2048, 384, 128, 0, 2048, GWR(128), ngw, lane); }
        for (int lw = 0; lw < 4; ++lw) conv_job(INP(lw & 1 ? 11 : 8) + (size_t)(lw >> 1) * 2048 * 128, 2048, 128, (bf16*)((unsigned char*)WC1 + (lw >> 1) * WC1_L), 2048, 0, 0, (lw & 1) * 256, scr, GWR(((2048) / 64) * (((128) + 31) / 32)), ngw, lane);
        for (int it = GWR(256); it < 256; it += ngw) {
            const int combo = it & 3, ch = it >> 2, ll = combo >> 1, which = combo & 1; const float* pe = INP(which ? 13 : 10) + (size_t)ll * 2048 + ch * 32; const float* w1 = INP(which ? 11 : 8) + (size_t)ll * 2048 * 128 + (size_t)ch * 32 * 128 + lane;
            float a0 = 0.f, a1 = 0.f;
#pragma unroll 8
            for (int kk = 0; kk < 32; ++kk) { const float p = pe[kk]; a0 += p * w1[kk * 128]; a1 += p * w1[kk * 128 + 64]; }
            CBPART[(size_t)it * 128 + lane] = a0; CBPART[(size_t)it * 128 + 64 + lane] = a1; }
        for (int idx = gw * 64 + lane; idx < NT * 16; idx += ngw * 64) { const int t = idx >> 4, i = idx & 15; const float ang = (float)((const int*)INP(1))[t] * rope_inv(i); ROPE[t * 32 + i] = cosf(ang); ROPE[t * 32 + 16 + i] = sinf(ang); }
        for (int row = gw; row < NT; row += 2 * ngw) { const int r1 = row + ngw < NT ? row + ngw : row; xn_row2(INP(0) + (size_t)row * DM, INP(0) + (size_t)r1 * DM, INP(18), XN + (size_t)row * DM, XN + (size_t)r1 * DM, lane); }
    #undef GWR
    }
    SEAM(PH_PRO);
    const unsigned uni = __builtin_amdgcn_readfirstlane(((volatile LAS unsigned*)(L + MISC_OFF))[8 + 2]);
    const int vb = uni ? (int)__builtin_amdgcn_readfirstlane(((volatile LAS unsigned*)(L + MISC_OFF))[8 + 3] * 8u + (xb_xcc_id() & 7u)) : (int)blockIdx.x;
#define SEAML(k) do { if (IN(k) && IN((k) + 1)) { XcdBarrier b_ = bar; GAS unsigned* bp_ = (GAS unsigned*)bar.bar; asm volatile("" : "+s"(bp_)); b_.bar = (unsigned*)bp_; if (uni) xcd_barrier_local(b_); else xcd_barrier(b_); } } while (0)
#define ROWMAP() const int rs_ = uni ? 2048 * (vb & 7) + (vb >> 3) * NWAVES + wave : gw, re_ = uni ? 2048 * ((vb & 7) + 1) : NT, rp_ = uni ? 256 : ngw

    { constexpr int l = 0;

    {
        const int pb = l == 0 ? L0_BASE : L1_BASE;

        if (IN(pb + J_INPROJ)) { BUFS(); pg8::Gemm g{XN, (const bf16*)((unsigned char*)WIN + l * WIN_L), NT, 2048, 1024}; pg8::StaticOrder S; S.init(NT, 2048, G, vb);
            pg8::EpiBf16s E{PROJ, NINP, NINP / 256, nullptr, nullptr}; pg8::gemm_phase<pg8::EpiBf16s, pg8::StaticOrder, true, true>(L, g, S, E, tid);
}
        SEAM(pb + J_INPROJ);
        if (IN(pb + J_PREP)) { BUFS();
            if (l == 0 && gw >= ngw - 64) { const int idx = (gw - (ngw - 64)) * 64 + lane, oi = idx >> 3, part = idx & 7, combo = oi >> 7, e = oi & 127;
                float a = 0.f;
#pragma unroll
                for (int j = 0; j < 8; ++j) a += CBPART[(size_t)((part * 8 + j) * 4 + combo) * 128 + e];
                a += shx(a, 1, lane); a += shx(a, 2, lane); a += shx(a, 4, lane);
                if (part == 0) CBIAS[oi] = a; }
            if (G >= 256) { if (blockIdx.x >= 128) for (int t = gw - 128 * NWAVES; t < NT; t += ngw - 128 * NWAVES)
                    mla_prep_row(PROJ + (size_t)t * NINP, ROPE + (size_t)t * 32, INP(4) + l * 256, INP(6) + l * 128, CQKV + (size_t)t * 384, KR + (size_t)t * 32, lane); }
            else for (int t = gw; t < NT; t += ngw) mla_prep_row(PROJ + (size_t)t * NINP, ROPE + (size_t)t * 32, INP(4) + l * 256, INP(6) + l * 128, CQKV + (size_t)t * 384, KR + (size_t)t * 32, lane);
            { pg8::Gemm g{XN, (const bf16*)((unsigned char*)WIN + l * WIN_L), NT, NINP, 1024}; TailColOrder S{G, (int)blockIdx.x};
              pg8::EpiBf16s E{PROJ, NINP, NINP / 256, nullptr, nullptr}; pg8::gemm_phase<pg8::EpiBf16s, TailColOrder, true, true>(L, g, S, E, tid); }
            __syncthreads();
            { pg8::Gemm g{PROJ, (const bf16*)((unsigned char*)WC1 + l * WC1_L), 0, 0, 512, 16 * NINP, 2048, NINP * 2, 1}; CompressOrder S{G, (int)blockIdx.x};
              pg8::EpiF32 E{HIDP, 128, 128}; pg8::gemm_phase<pg8::EpiF32, CompressOrder, true, true>(L, g, S, E, tid); }
        }
        SEAM(pb + J_PREP);
        if (IN(pb + J_MLAUP)) { BUFS(); pg8::Gemm g{CQKV, (const bf16*)((unsigned char*)WUP + l * WUP_L), NT, 1024, 384}; pg8::StaticOrder S; S.init(NT, 1024, G, (int)blockIdx.x);
            pg8::EpiMlaUp E{QB, KVB}; pg8::gemm_phase<pg8::EpiMlaUp, pg8::StaticOrder, true, true>(L, g, S, E, tid);
            LAS float* hb = (LAS float*)(L + wave * 1024);
            for (int it = gw; it < NB * NCMP * 4; it += ngw) { const int which = it & 1, g2 = (it >> 1) & 1, bn = it >> 2, n = bn % NCMP, b = bn / NCMP;
                compress_finish_item(HIDP, CBIAS + (l * 2 + which) * 128, INP(which ? 12 : 9) + (size_t)l * 128 * 64, which ? VCB : KCB, b, g2, which, n, hb, lane); }
            if (gw < 16) { bf16* z = (gw & 1 ? VCB : KCB) + ((size_t)(gw >> 1) * 256 + 255) * 64; z[lane] = 0; }
        }
        SEAM(pb + J_MLAUP);
        if (IN(pb + J_ATTN)) { BUFS();
            const int xq = (int)(xb_xcc_id() & 7u);
            gu32* qb = ctl + CW_QX + 64 * ((pb + J_ATTN) * 8 + xq); LAS int* slot = (LAS int*)(L + RING_BYTES + 512);
            int nxt = 0; if (threadIdx.x == 0) nxt = (int)__hip_atomic_fetch_add(qb, 1u, RLX_AGENT);
            for (;;) { int tq_; asm volatile("v_mbcnt_lo_u32_b32 %0, -1, 0\n\tv_mbcnt_hi_u32_b32 %0, -1, %0" : "=v"(tq_)); tq_ += wave_s * 64;
                if (tq_ == 0) *slot = nxt;
                __syncthreads();
                const int nprep = 0, NCX = ((l == 0 ? NCH_GU + NCH_F : NCH_D) - nprep) / 8, QT = 192 + NCX;
                int it = *slot; if (it >= 32 + QT) break;
                if (tq_ == 0) nxt = (int)__hip_atomic_fetch_add(qb, 1u, RLX_AGENT);
                int cchunk = -1; if (it >= 32) { const int p = it - 32, nc = p * NCX / QT; if ((p + 1) * NCX / QT > nc) cchunk = nc; else it = 32 + p - nc; }
                if (cchunk >= 0) {
                    WCONV_CHUNK(nprep + cchunk * 8 + xq, wave_s, tq_ & 63);
                    continue; }
                if (it < 32) { const int bh = 2 * xq + (it >> 4), s = it & 15; attn_b_unit(L, QB, KVB, KR, ROPE, MIXED, SSQ0, bh >> 2, bh & 3, 31 - s, tq_); asm volatile("" : "+v"(tq_)); attn_b_unit(L, QB, KVB, KR, ROPE, MIXED, SSQ0, bh >> 2, bh & 3, s, tq_); }
                else if (it < 160) { attn_c_unit(L, PROJ, KCB, VCB, MIXED, SSQ0, xq >> 1, xq & 1, 127 - (it - 32), tq_); }
                else { attn_a_unit(L, PROJ, INP(3) + l * 4, MIXED, SSQ0, xq >> 1, xq & 1, it - 160, tq_); } }
        }
        SEAM(pb + J_ATTN);
        if (IN(pb + J_WO)) { BUFS(); pg8::StaticOrder S; S.init(NT, 1024, G, vb); LAS float* rt = (LAS float*)(L + RING_BYTES + 4096);
            for (int i = 0; ; ++i) { pg8::Unit u; if (!S.next(i, u)) break;
                __syncthreads();
                if (tid < 256) { const f32x4* qp = (const f32x4*)(SSQ0 + (size_t)(u.pm * 256 + tid) * 16); const f32x4 qa = qp[0], qb = qp[1], qc = qp[2], qd = qp[3];
                    const float sa = (qa[0] + qa[1]) + (qa[2] + qa[3]), sb = (qb[0] + qb[1]) + (qb[2] + qb[3]), sc = ((qc[0] + qc[1]) + (qc[2] + qc[3])) + ((qd[0] + qd[1]) + (qd[2] + qd[3]));
                    const float ra = 1.0f / sqrtf(sa * (1.0f / 256) + EPS), rb = 1.0f / sqrtf(sb * (1.0f / 256) + EPS), rc = 1.0f / sqrtf(sc * (1.0f / 512) + EPS);
                    rt[4 * tid] = ra / rb; rt[4 * tid + 1] = rb / rc; rt[4 * tid + 2] = rc; }
                __syncthreads();
                pg8::Gemm g{MIXED, (const bf16*)((unsigned char*)WO + l * WO_L), NT, 1024, 1024}; OneUnit S1{u};
                pg8::EpiWo E{MOUT, DM, rt}; pg8::gemm_phase<pg8::EpiWo, OneUnit, true, true>(L, g, S1, E, tid); } }
        SEAML(pb + J_WO);
        if (IN(pb + J_RESN)) { BUFS();
            const float* xsrc = l == 0 ? INP(0) : (const float*)xo; ROWMAP();
            for (int t0 = rs_; t0 < re_; t0 += 2 * rp_) { const int t1 = t0 + rp_ < re_ ? t0 + rp_ : t0; f32x4 m0[4], m1[4], x0[4], x1[4];
#pragma unroll
                for (int j = 0; j < 4; ++j) { const uint2 w0 = ((const uint2*)(MOUT + (size_t)t0 * DM))[lane + 64 * j], w1 = ((const uint2*)(MOUT + (size_t)t1 * DM))[lane + 64 * j];
                    m0[j] = (f32x4){bflo(w0.x), bfhi(w0.x), bflo(w0.y), bfhi(w0.y)}; m1[j] = (f32x4){bflo(w1.x), bfhi(w1.x), bflo(w1.y), bfhi(w1.y)};
                    x0[j] = ((const f32x4*)(xsrc + (size_t)t0 * DM))[lane + 64 * j]; x1[j] = ((const f32x4*)(xsrc + (size_t)t1 * DM))[lane + 64 * j]; }
                resnorm_row(m0, x0, INP(19) + l * DM, l == 0 ? nullptr : xo + (size_t)t0 * DM, INP(20) + l * DM, XN + (size_t)t0 * DM, l == 1 ? INP(25) : nullptr, t0, TOKE, TOKP, TOKW, cnt, lane, l == 1 ? (unsigned char*)AG : nullptr, ROWWE);
                if (t1 != t0) resnorm_row(m1, x1, INP(19) + l * DM, l == 0 ? nullptr : xo + (size_t)t1 * DM, INP(20) + l * DM, XN + (size_t)t1 * DM, l == 1 ? INP(25) : nullptr, t1, TOKE, TOKP, TOKW, cnt, lane, l == 1 ? (unsigned char*)AG : nullptr, ROWWE); }
        }
        if (l == 0) SEAML(pb + J_RESN); else SEAM(pb + J_RESN);
        if (l == 0) {
            if (IN(pb + J_F1)) { BUFS(); pg8::Gemm g{XN, WGU, NT, 2 * DFF, 1024}; pg8::StaticOrder S; S.init(NT, 2 * DFF, G, vb);
                pg8::EpiSwiGLU8 E{(unsigned char*)HIDB, DFF, DFF / 128}; pg8::gemm_phase<pg8::EpiSwiGLU8, pg8::StaticOrder, true, true>(L, g, S, E, tid); }
            SEAML(pb + J_F1);
            if (IN(pb + J_F2)) { BUFS(); pg8::Gemm g{HIDB, WD, NT, 1024, DFF / 2}; pg8::StaticOrder S; S.init(NT, 1024, G, vb);
                pg8::EpiBf16s E{FOUT, DM, 4, nullptr, nullptr}; pg8::gemm_phase<pg8::EpiBf16s, pg8::StaticOrder, true, true, F8S_D>(L, g, S, E, tid); }
            SEAML(pb + J_F2);
            if (IN(pb + J_F3)) { BUFS(); ROWMAP();
                for (int t0 = rs_; t0 < re_; t0 += 2 * rp_) { const int t1 = t0 + rp_ < re_ ? t0 + rp_ : t0; f32x4 m0[4], m1[4], x0[4], x1[4]; uint2 p0[4], p1[4];
#pragma unroll
                    for (int j = 0; j < 4; ++j) { const uint2 w0 = ((const uint2*)(FOUT + (size_t)t0 * DM))[lane + 64 * j], w1 = ((const uint2*)(FOUT + (size_t)t1 * DM))[lane + 64 * j];
                        m0[j] = (f32x4){bflo(w0.x), bfhi(w0.x), bflo(w0.y), bfhi(w0.y)}; m1[j] = (f32x4){bflo(w1.x), bfhi(w1.x), bflo(w1.y), bfhi(w1.y)};
                        x0[j] = ((const f32x4*)(INP(0) + (size_t)t0 * DM))[lane + 64 * j]; x1[j] = ((const f32x4*)(INP(0) + (size_t)t1 * DM))[lane + 64 * j];
                        p0[j] = ((const uint2*)(MOUT + (size_t)t0 * DM))[lane + 64 * j]; p1[j] = ((const uint2*)(MOUT + (size_t)t1 * DM))[lane + 64 * j]; }
                    add_post(x0, p0, INP(19), lane); add_post(x1, p1, INP(19), lane);
                    resnorm_row(m0, x0, INP(21), xo + (size_t)t0 * DM, INP(18) + DM, XN + (size_t)t0 * DM, nullptr, t0, TOKE, TOKP, TOKW, cnt, lane);
                    if (t1 != t0) resnorm_row(m1, x1, INP(21), xo + (size_t)t1 * DM, INP(18) + DM, XN + (size_t)t1 * DM, nullptr, t1, TOKE, TOKP, TOKW, cnt, lane); }
            }
            SEAML(pb + J_F3);
        } else {
            if (IN(pb + J_F1)) { BUFS(); moe_table(cnt, tab, tid);
                pg8::Gemm g{AG, MGU, MOE_ROWS, NEXP * 2 * DFE, 1024 / 2, 0, 0, 0, 1}; MoeOrder S{2 * DFE / 256, G, (int)blockIdx.x, tab, 0, 1};
                pg8::EpiSwiGLU8 E{(unsigned char*)HIDM, DFE, 2 * DFE / 256}; pg8::gemm_phase<pg8::EpiSwiGLU8, MoeOrder, true, true, F8S_GU>(L, g, S, E, tid); }
            SEAM(pb + J_F1);
            if (IN(pb + J_F2)) { BUFS(); moe_table(cnt, tab, tid);
                { pg8::Gemm g{HIDM, MD, MOE_ROWS, NEXP * 1024, DFE / 2}; MoeOrder S{4, G, (int)blockIdx.x, tab, 128};
                  pg8::EpiF8s E{(unsigned char*)PAIR, 4, ROWWE, tab, (float)(1 << F8_PAIR)}; pg8::gemm_phase<pg8::EpiF8s, MoeOrder, true, true, F8S_D>(L, g, S, E, tid); }
                __syncthreads();
                { pg8::Gemm g{HIDM, MD, MOE_ROWS, NEXP * 1024, 512 / 2, DFE / 2, DFE / 2, 0, 1}; MoeTailOrder S{G, (int)blockIdx.x, tab};
                  pg8::EpiPart E{PART, ROWWE, tab}; pg8::gemm_phase<pg8::EpiPart, MoeTailOrder, true, true, F8S_D>(L, g, S, E, tid); } }
            SEAM(pb + J_F2);
            if (IN(pb + J_F3)) { BUFS(); moe_table(cnt, tab, tid);
                for (int t0 = gw; t0 < NT; t0 += 2 * ngw) { const int t1 = t0 + ngw < NT ? t0 + ngw : t0;
                    const int r00 = tab[TOKE[2 * t0]] + TOKP[2 * t0], r01 = tab[TOKE[2 * t0 + 1]] + TOKP[2 * t0 + 1], r10 = tab[TOKE[2 * t1]] + TOKP[2 * t1], r11 = tab[TOKE[2 * t1 + 1]] + TOKP[2 * t1 + 1];
                    f32x4 m0[4], m1[4], x0[4], x1[4];
#pragma unroll
                    for (int j = 0; j < 4; ++j) { m0[j] = pair_vals(PAIR, PART, r00, lane + 64 * j) + pair_vals(PAIR, PART, r01, lane + 64 * j); m1[j] = pair_vals(PAIR, PART, r10, lane + 64 * j) + pair_vals(PAIR, PART, r11, lane + 64 * j);
                        x0[j] = ((const f32x4*)(xo + (size_t)t0 * DM))[lane + 64 * j]; x1[j] = ((const f32x4*)(xo + (size_t)t1 * DM))[lane + 64 * j]; }
                    resnorm_row(m0, x0, INP(21) + DM, xo + (size_t)t0 * DM, nullptr, nullptr, nullptr, t0, TOKE, TOKP, TOKW, cnt, lane);
                    if (t1 != t0) resnorm_row(m1, x1, INP(21) + DM, xo + (size_t)t1 * DM, nullptr, nullptr, nullptr, t1, TOKE, TOKP, TOKW, cnt, lane); }
            }
        }
    }
        }
    { constexpr int l = 1;

    {
        const int pb = l == 0 ? L0_BASE : L1_BASE;

        if (IN(pb + J_INPROJ)) { BUFS(); pg8::Gemm g{XN, (const bf16*)((unsigned char*)WIN + l * WIN_L), NT, 2048, 1024}; pg8::StaticOrder S; S.init(NT, 2048, G, vb);
            pg8::EpiBf16s E{PROJ, NINP, NINP / 256, nullptr, nullptr}; pg8::gemm_phase<pg8::EpiBf16s, pg8::StaticOrder, true, true>(L, g, S, E, tid);
}
        SEAM(pb + J_INPROJ);
        if (IN(pb + J_PREP)) { BUFS();
            if (l == 0 && gw >= ngw - 64) { const int idx = (gw - (ngw - 64)) * 64 + lane, oi = idx >> 3, part = idx & 7, combo = oi >> 7, e = oi & 127;
                float a = 0.f;
#pragma unroll
                for (int j = 0; j < 8; ++j) a += CBPART[(size_t)((part * 8 + j) * 4 + combo) * 128 + e];
                a += shx(a, 1, lane); a += shx(a, 2, lane); a += shx(a, 4, lane);
                if (part == 0) CBIAS[oi] = a; }
            if (G >= 256) { if (blockIdx.x >= 128) for (int t = gw - 128 * NWAVES; t < NT; t += ngw - 128 * NWAVES)
                    mla_prep_row(PROJ + (size_t)t * NINP, ROPE + (size_t)t * 32, INP(4) + l * 256, INP(6) + l * 128, CQKV + (size_t)t * 384, KR + (size_t)t * 32, lane); }
            else for (int t = gw; t < NT; t += ngw) mla_prep_row(PROJ + (size_t)t * NINP, ROPE + (size_t)t * 32, INP(4) + l * 256, INP(6) + l * 128, CQKV + (size_t)t * 384, KR + (size_t)t * 32, lane);
            { pg8::Gemm g{XN, (const bf16*)((unsigned char*)WIN + l * WIN_L), NT, NINP, 1024}; TailColOrder S{G, (int)blockIdx.x};
              pg8::EpiBf16s E{PROJ, NINP, NINP / 256, nullptr, nullptr}; pg8::gemm_phase<pg8::EpiBf16s, TailColOrder, true, true>(L, g, S, E, tid); }
            __syncthreads();
            { pg8::Gemm g{PROJ, (const bf16*)((unsigned char*)WC1 + l * WC1_L), 0, 0, 512, 16 * NINP, 2048, NINP * 2, 1}; CompressOrder S{G, (int)blockIdx.x};
              pg8::EpiF32 E{HIDP, 128, 128}; pg8::gemm_phase<pg8::EpiF32, CompressOrder, true, true>(L, g, S, E, tid); }
        }
        SEAM(pb + J_PREP);
        if (IN(pb + J_MLAUP)) { BUFS(); pg8::Gemm g{CQKV, (const bf16*)((unsigned char*)WUP + l * WUP_L), NT, 1024, 384}; pg8::StaticOrder S; S.init(NT, 1024, G, (int)blockIdx.x);
            pg8::EpiMlaUp E{QB, KVB}; pg8::gemm_phase<pg8::EpiMlaUp, pg8::StaticOrder, true, true>(L, g, S, E, tid);
            LAS float* hb = (LAS float*)(L + wave * 1024);
            for (int it = gw; it < NB * NCMP * 4; it += ngw) { const int which = it & 1, g2 = (it >> 1) & 1, bn = it >> 2, n = bn % NCMP, b = bn / NCMP;
                compress_finish_item(HIDP, CBIAS + (l * 2 + which) * 128, INP(which ? 12 : 9) + (size_t)l * 128 * 64, which ? VCB : KCB, b, g2, which, n, hb, lane); }
            if (gw < 16) { bf16* z = (gw & 1 ? VCB : KCB) + ((size_t)(gw >> 1) * 256 + 255) * 64; z[lane] = 0; }
        }
        SEAM(pb + J_MLAUP);
        if (IN(pb + J_ATTN)) { BUFS();
            const int xq = (int)(xb_xcc_id() & 7u);
            gu32* qb = ctl + CW_QX + 64 * ((pb + J_ATTN) * 8 + xq); LAS int* slot = (LAS int*)(L + RING_BYTES + 512);
            int nxt = 0; if (threadIdx.x == 0) nxt = (int)__hip_atomic_fetch_add(qb, 1u, RLX_AGENT);
            for (;;) { int tq_; asm volatile("v_mbcnt_lo_u32_b32 %0, -1, 0\n\tv_mbcnt_hi_u32_b32 %0, -1, %0" : "=v"(tq_)); tq_ += wave_s * 64;
                if (tq_ == 0) *slot = nxt;
                __syncthreads();
                const int nprep = 0, NCX = ((l == 0 ? NCH_GU + NCH_F : NCH_D) - nprep) / 8, QT = 192 + NCX;
                int it = *slot; if (it >= 32 + QT) break;
                if (tq_ == 0) nxt = (int)__hip_atomic_fetch_add(qb, 1u, RLX_AGENT);
                int cchunk = -1; if (it >= 32) { const int p = it - 32, nc = p * NCX / QT; if ((p + 1) * NCX / QT > nc) cchunk = nc; else it = 32 + p - nc; }
                if (cchunk >= 0) {
                    WCONV_CHUNK(nprep + cchunk * 8 + xq, wave_s, tq_ & 63);
                    continue; }
                if (it < 32) { const int bh = 2 * xq + (it >> 4), s = it & 15; attn_b_unit(L, QB, KVB, KR, ROPE, MIXED, SSQ0, bh >> 2, bh & 3, 31 - s, tq_); asm volatile("" : "+v"(tq_)); attn_b_unit(L, QB, KVB, KR, ROPE, MIXED, SSQ0, bh >> 2, bh & 3, s, tq_); }
                else if (it < 160) { attn_c_unit(L, PROJ, KCB, VCB, MIXED, SSQ0, xq >> 1, xq & 1, 127 - (it - 32), tq_); }
                else { attn_a_unit(L, PROJ, INP(3) + l * 4, MIXED, SSQ0, xq >> 1, xq & 1, it - 160, tq_); } }
        }
        SEAM(pb + J_ATTN);
        if (IN(pb + J_WO)) { BUFS(); pg8::StaticOrder S; S.init(NT, 1024, G, vb); LAS float* rt = (LAS float*)(L + RING_BYTES + 4096);
            for (int i = 0; ; ++i) { pg8::Unit u; if (!S.next(i, u)) break;
                __syncthreads();
                if (tid < 256) { const f32x4* qp = (const f32x4*)(SSQ0 + (size_t)(u.pm * 256 + tid) * 16); const f32x4 qa = qp[0], qb = qp[1], qc = qp[2], qd = qp[3];
                    const float sa = (qa[0] + qa[1]) + (qa[2] + qa[3]), sb = (qb[0] + qb[1]) + (qb[2] + qb[3]), sc = ((qc[0] + qc[1]) + (qc[2] + qc[3])) + ((qd[0] + qd[1]) + (qd[2] + qd[3]));
                    const float ra = 1.0f / sqrtf(sa * (1.0f / 256) + EPS), rb = 1.0f / sqrtf(sb * (1.0f / 256) + EPS), rc = 1.0f / sqrtf(sc * (1.0f / 512) + EPS);
                    rt[4 * tid] = ra / rb; rt[4 * tid + 1] = rb / rc; rt[4 * tid + 2] = rc; }
                __syncthreads();
                pg8::Gemm g{MIXED, (const bf16*)((unsigned char*)WO + l * WO_L), NT, 1024, 1024}; OneUnit S1{u};
                pg8::EpiWo E{MOUT, DM, rt}; pg8::gemm_phase<pg8::EpiWo, OneUnit, true, true>(L, g, S1, E, tid); } }
        SEAML(pb + J_WO);
        if (IN(pb + J_RESN)) { BUFS();
            const float* xsrc = l == 0 ? INP(0) : (const float*)xo; ROWMAP();
            for (int t0 = rs_; t0 < re_; t0 += 2 * rp_) { const int t1 = t0 + rp_ < re_ ? t0 + rp_ : t0; f32x4 m0[4], m1[4], x0[4], x1[4];
#pragma unroll
                for (int j = 0; j < 4; ++j) { const uint2 w0 = ((const uint2*)(MOUT + (size_t)t0 * DM))[lane + 64 * j], w1 = ((const uint2*)(MOUT + (size_t)t1 * DM))[lane + 64 * j];
                    m0[j] = (f32x4){bflo(w0.x), bfhi(w0.x), bflo(w0.y), bfhi(w0.y)}; m1[j] = (f32x4){bflo(w1.x), bfhi(w1.x), bflo(w1.y), bfhi(w1.y)};
                    x0[j] = ((const f32x4*)(xsrc + (size_t)t0 * DM))[lane + 64 * j]; x1[j] = ((const f32x4*)(xsrc + (size_t)t1 * DM))[lane + 64 * j]; }
                resnorm_row(m0, x0, INP(19) + l * DM, l == 0 ? nullptr : xo + (size_t)t0 * DM, INP(20) + l * DM, XN + (size_t)t0 * DM, l == 1 ? INP(25) : nullptr, t0, TOKE, TOKP, TOKW, cnt, lane, l == 1 ? (unsigned char*)AG : nullptr, ROWWE);
                if (t1 != t0) resnorm_row(m1, x1, INP(19) + l * DM, l == 0 ? nullptr : xo + (size_t)t1 * DM, INP(20) + l * DM, XN + (size_t)t1 * DM, l == 1 ? INP(25) : nullptr, t1, TOKE, TOKP, TOKW, cnt, lane, l == 1 ? (unsigned char*)AG : nullptr, ROWWE); }
        }
        if (l == 0) SEAML(pb + J_RESN); else SEAM(pb + J_RESN);
        if (l == 0) {
            if (IN(pb + J_F1)) { BUFS(); pg8::Gemm g{XN, WGU, NT, 2 * DFF, 1024}; pg8::StaticOrder S; S.init(NT, 2 * DFF, G, vb);
                pg8::EpiSwiGLU8 E{(unsigned char*)HIDB, DFF, DFF / 128}; pg8::gemm_phase<pg8::EpiSwiGLU8, pg8::StaticOrder, true, true>(L, g, S, E, tid); }
            SEAML(pb + J_F1);
            if (IN(pb + J_F2)) { BUFS(); pg8::Gemm g{HIDB, WD, NT, 1024, DFF / 2}; pg8::StaticOrder S; S.init(NT, 1024, G, vb);
                pg8::EpiBf16s E{FOUT, DM, 4, nullptr, nullptr}; pg8::gemm_phase<pg8::EpiBf16s, pg8::StaticOrder, true, true, F8S_D>(L, g, S, E, tid); }
            SEAML(pb + J_F2);
            if (IN(pb + J_F3)) { BUFS(); ROWMAP();
                for (int t0 = rs_; t0 < re_; t0 += 2 * rp_) { const int t1 = t0 + rp_ < re_ ? t0 + rp_ : t0; f32x4 m0[4], m1[4], x0[4], x1[4]; uint2 p0[4], p1[4];
#pragma unroll
                    for (int j = 0; j < 4; ++j) { const uint2 w0 = ((const uint2*)(FOUT + (size_t)t0 * DM))[lane + 64 * j], w1 = ((const uint2*)(FOUT + (size_t)t1 * DM))[lane + 64 * j];
                        m0[j] = (f32x4){bflo(w0.x), bfhi(w0.x), bflo(w0.y), bfhi(w0.y)}; m1[j] = (f32x4){bflo(w1.x), bfhi(w1.x), bflo(w1.y), bfhi(w1.y)};
                        x0[j] = ((const f32x4*)(INP(0) + (size_t)t0 * DM))[lane + 64 * j]; x1[j] = ((const f32x4*)(INP(0) + (size_t)t1 * DM))[lane + 64 * j];
                        p0[j] = ((const uint2*)(MOUT + (size_t)t0 * DM))[lane + 64 * j]; p1[j] = ((const uint2*)(MOUT + (size_t)t1 * DM))[lane + 64 * j]; }
                    add_post(x0, p0, INP(19), lane); add_post(x1, p1, INP(19), lane);
                    resnorm_row(m0, x0, INP(21), xo + (size_t)t0 * DM, INP(18) + DM, XN + (size_t)t0 * DM, nullptr, t0, TOKE, TOKP, TOKW, cnt, lane);
                    if (t1 != t0) resnorm_row(m1, x1, INP(21), xo + (size_t)t1 * DM, INP(18) + DM, XN + (size_t)t1 * DM, nullptr, t1, TOKE, TOKP, TOKW, cnt, lane); }
            }
            SEAML(pb + J_F3);
        } else {
            if (IN(pb + J_F1)) { BUFS(); moe_table(cnt, tab, tid);
                pg8::Gemm g{AG, MGU, MOE_ROWS, NEXP * 2 * DFE, 1024 / 2, 0, 0, 0, 1}; MoeOrder S{2 * DFE / 256, G, (int)blockIdx.x, tab, 0, 1};
                pg8::EpiSwiGLU8 E{(unsigned char*)HIDM, DFE, 2 * DFE / 256}; pg8::gemm_phase<pg8::EpiSwiGLU8, MoeOrder, true, true, F8S_GU>(L, g, S, E, tid); }
            SEAM(pb + J_F1);
            if (IN(pb + J_F2)) { BUFS(); moe_table(cnt, tab, tid);
                { pg8::Gemm g{HIDM, MD, MOE_ROWS, NEXP * 1024, DFE / 2}; MoeOrder S{4, G, (int)blockIdx.x, tab, 128};
                  pg8::EpiF8s E{(unsigned char*)PAIR, 4, ROWWE, tab, (float)(1 << F8_PAIR)}; pg8::gemm_phase<pg8::EpiF8s, MoeOrder, true, true, F8S_D>(L, g, S, E, tid); }
                __syncthreads();
                { pg8::Gemm g{HIDM, MD, MOE_ROWS, NEXP * 1024, 512 / 2, DFE / 2, DFE / 2, 0, 1}; MoeTailOrder S{G, (int)blockIdx.x, tab};
                  pg8::EpiPart E{PART, ROWWE, tab}; pg8::gemm_phase<pg8::EpiPart, MoeTailOrder, true, true, F8S_D>(L, g, S, E, tid); } }
            SEAM(pb + J_F2);
            if (IN(pb + J_F3)) { BUFS(); moe_table(cnt, tab, tid);
                for (int t0 = gw; t0 < NT; t0 += 2 * ngw) { const int t1 = t0 + ngw < NT ? t0 + ngw : t0;
                    const int r00 = tab[TOKE[2 * t0]] + TOKP[2 * t0], r01 = tab[TOKE[2 * t0 + 1]] + TOKP[2 * t0 + 1], r10 = tab[TOKE[2 * t1]] + TOKP[2 * t1], r11 = tab[TOKE[2 * t1 + 1]] + TOKP[2 * t1 + 1];
                    f32x4 m0[4], m1[4], x0[4], x1[4];
#pragma unroll
                    for (int j = 0; j < 4; ++j) { m0[j] = pair_vals(PAIR, PART, r00, lane + 64 * j) + pair_vals(PAIR, PART, r01, lane + 64 * j); m1[j] = pair_vals(PAIR, PART, r10, lane + 64 * j) + pair_vals(PAIR, PART, r11, lane + 64 * j);
                        x0[j] = ((const f32x4*)(xo + (size_t)t0 * DM))[lane + 64 * j]; x1[j] = ((const f32x4*)(xo + (size_t)t1 * DM))[lane + 64 * j]; }
                    resnorm_row(m0, x0, INP(21) + DM, xo + (size_t)t0 * DM, nullptr, nullptr, nullptr, t0, TOKE, TOKP, TOKW, cnt, lane);
                    if (t1 != t0) resnorm_row(m1, x1, INP(21) + DM, xo + (size_t)t1 * DM, nullptr, nullptr, nullptr, t1, TOKE, TOKP, TOKW, cnt, lane); }
            }
        }
    }
        }

#undef IN
#undef SEAM
#undef SEAML
#undef ROWMAP
}

#ifndef MK_PER_PHASE
#define MK_PER_PHASE 0
#endif
extern "C" void kernel_launch(void* const* d_in, const int* in_sizes, int n_in, void* d_out, int out_size, void* d_ws, size_t ws_size, hipStream_t stream) {
    if (ws_size < WS_END || n_in != 29) return;
    static int grid = 0;
    if (!grid) { int dev = 0, cus = 0; (void)hipGetDevice(&dev); (void)hipDeviceGetAttribute(&cus, hipDeviceAttributeMultiprocessorCount, dev);
        (void)hipFuncSetAttribute((const void*)mk, hipFuncAttributeMaxDynamicSharedMemorySize, LDS_BYTES); (void)hipGetLastError(); grid = cus > 0 ? cus : 256; }
    unsigned char* ws = (unsigned char*)d_ws;
    (void)hipMemsetAsync(ws + WS_CTL, 0, CTL_ZERO_BYTES, stream);
    MkArgs a{}; for (int i = 0; i < 29; ++i) a.in[i] = (const float*)d_in[i]; a.out = (float*)d_out; a.ws = ws;
#if MK_PER_PHASE
    for (int p = 0; p < NPH; ++p) { a.ph_lo = p; a.ph_hi = p + 1; hipLaunchKernelGGL(mk, dim3(grid), dim3(NWAVES * 64), LDS_BYTES, stream, a); }
#else
    a.ph_lo = 0; a.ph_hi = NPH; hipLaunchKernelGGL(mk, dim3(grid), dim3(NWAVES * 64), LDS_BYTES, stream, a);
#endif
}
```

```cpp
#include <hip/hip_runtime.h>
#include <stdint.h>
#include <math.h>
#include <cstdio>

namespace pg8 {
#define PG8_LAS __attribute__((address_space(3)))
typedef unsigned short bf16_t;
typedef short bf16x8 __attribute__((ext_vector_type(8)));
typedef float f32x4 __attribute__((ext_vector_type(4)));
typedef unsigned u32x4 __attribute__((ext_vector_type(4)));
constexpr int BM = 256, BK = 64, HALF = 128, HTB = HALF * BK * 2  , STAGE_BYTES = 8 * HTB, NXCD = 8, WGM = 8;

__host__ __device__ __forceinline__ int lds_byte(int r, int c) { const int st = (r >> 4) * 2 + (c >> 5), rr = r & 15, cc = c & 31, ob = rr * 64 + cc * 2; return st * 1024 + (ob ^ (((ob >> 9) & 1) << 5)); }
__host__ __device__ __forceinline__ void stage_rc(int b, int& R, int& C) { const int st = b / 1024, sb = b % 1024, swz = sb ^ (((sb >> 9) & 1) << 5); R = (st >> 1) * 16 + swz / 64; C = (st & 1) * 32 + (swz % 64) / 2; }
__host__ __device__ __forceinline__ int perm32(int rho) { const int n = rho >> 4, i = rho & 15; return 8 * (i >> 2) + 4 * n + (i & 3); }

struct Unit { int pm, pn; long aoff, boff; };
struct Gemm { const bf16_t* A; const bf16_t* Bt; int M, N, K; int lda, ldb, akstep, uoff; };

struct StaticOrder {
    int nM, nN, nwg, G, c;
    __host__ __device__ __forceinline__ void init(int M, int N, int G_, int c_) { nM = M / BM; nN = N / BM; nwg = nM * nN; G = G_; c = c_; }
    __host__ __device__ __forceinline__ bool next(int i, Unit& u) const {
        const long L = (long)i * G + c; if (L >= nwg) return false;
        int wgid = (int)L; { const int q = nwg / NXCD, r = nwg % NXCD, xcd = wgid % NXCD, off = wgid / NXCD; wgid = (xcd < r ? xcd * (q + 1) : r * (q + 1) + (xcd - r) * q) + off; }
        const int nig = WGM * nN, gid = wgid / nig, fm = gid * WGM, gsz = (nM - fm) < WGM ? (nM - fm) : WGM;
        u.pm = fm + ((wgid % nig) % gsz); u.pn = (wgid % nig) / gsz; u.aoff = 0; u.boff = 0; return true;
    }
    __device__ __forceinline__ void a_ready(const Unit&) const {}
    __device__ __forceinline__ void done(const Unit&) const {}
};
__device__ __forceinline__ unsigned cvt_pk_bf16(float lo, float hi) { unsigned r; asm volatile("v_cvt_pk_bf16_f32 %0, %1, %2" : "=v"(r) : "v"(lo), "v"(hi)); return r; }
typedef float f32x2 __attribute__((ext_vector_type(2)));
typedef int i32x4 __attribute__((ext_vector_type(4)));
typedef int i32x8 __attribute__((ext_vector_type(8)));
__device__ __forceinline__ i32x8 cat8(bf16x8 lo, bf16x8 hi) { return __builtin_shufflevector(__builtin_bit_cast(i32x4, lo), __builtin_bit_cast(i32x4, hi), 0, 1, 2, 3, 4, 5, 6, 7); }
template <class Epi, class Sched, bool ALIGN_EPI = false, bool SP2 = false, int F8S = 0>
__device__ __forceinline__ void gemm_phase(PG8_LAS unsigned char* lds, const Gemm g, const Sched& S, const Epi& E, int tid_in) {
    int tid_ = tid_in; asm volatile("" : "+v"(tid_));
    const int tid = tid_, wid = __builtin_amdgcn_readfirstlane(tid >> 6), lane = tid & 63, wr = wid >> 2, wc = wid & 3, fr = lane & 15, fq = lane >> 4;
    int nt_ = g.K / BK; asm volatile("" : "+s"(nt_));
    const int K = g.K, nt = nt_, lda = g.lda ? g.lda : K, ldb = g.ldb ? g.ldb : K;
    unsigned voffA[2], voffB[2];
#pragma unroll
    for (int i = 0; i < 2; ++i) { int R, C; stage_rc(tid * 16 + i * 8192, R, C); const int Rb = Epi::PERM ? ((R & ~31) + perm32(R & 31)) : R;
        voffA[i] = (unsigned)(R * lda + C) * 2u; voffB[i] = (unsigned)(Rb * ldb + C) * 2u; }
    const size_t kstepB = (size_t)(BK * 2), kstepA = g.akstep ? (size_t)g.akstep : kstepB;
    const size_t hstepA = (size_t)HALF * lda * 2, hstepB = (size_t)HALF * ldb * 2;
    const size_t tstepA = 2 * hstepA, tstepB = 2 * hstepB;
    const unsigned ldsw = (unsigned)wid * 1024u;
    const int aoff = lds_byte(wr * 64 + fr, fq * 8), boff = lds_byte(wc * 32 + fr, fq * 8);
#define PG8_SA(b, h) (((b) * 2 + (h)) * HTB)
#define PG8_SB(b, h) ((4 + (b) * 2 + (h)) * HTB)
#define PG8_STAGE(bufoff, gbase, voff) do { const char* gb_ = (const char*)(gbase); asm volatile("" : "+s"(gb_));     \
        _Pragma("unroll") for (int _i = 0; _i < 2; ++_i) \
        __builtin_amdgcn_global_load_lds((const unsigned*)(gb_ + (voff)[_i]), (PG8_LAS unsigned*)(lds + (bufoff) + ldsw + _i * 8192), 16, 0, 0); } while (0)
#define PG8_LDA(dst, b, h) do { _Pragma("unroll") for (int m = 0; m < 4; ++m) _Pragma("unroll") for (int k = 0; k < 2; ++k) dst[m][k] = *(const PG8_LAS bf16x8*)(lds + PG8_SA(b, h) + aoff + m * 2048 + k * 1024); } while (0)
#define PG8_LDB(dst, b, h) do { _Pragma("unroll") for (int n = 0; n < 2; ++n) _Pragma("unroll") for (int k = 0; k < 2; ++k) dst[n][k] = *(const PG8_LAS bf16x8*)(lds + PG8_SB(b, h) + boff + n * 2048 + k * 1024); } while (0)
#define PG8_MMA(ai, bj, At, Bt) do { __builtin_amdgcn_s_setprio(1); _Pragma("unroll") for (int m = 0; m < 4; ++m) _Pragma("unroll") for (int n = 0; n < 2; ++n) { \
        if constexpr (F8S != 0) acc[ai][bj][m][n] = __builtin_amdgcn_mfma_scale_f32_16x16x128_f8f6f4(cat8(Bt[n][0], Bt[n][1]), cat8(At[m][0], At[m][1]), acc[ai][bj][m][n], 0, 0, 0, F8S >> 8, 0, F8S & 255); \
        else { _Pragma("unroll") for (int k = 0; k < 2; ++k) acc[ai][bj][m][n] = __builtin_amdgcn_mfma_f32_16x16x32_bf16(Bt[n][k], At[m][k], acc[ai][bj][m][n], 0, 0, 0); } } __builtin_amdgcn_s_setprio(0); } while (0)
#define PG8_WAIT_V(n) asm volatile("s_waitcnt vmcnt(" #n ")" ::: "memory")
#define PG8_WAIT_L(n) asm volatile("s_waitcnt lgkmcnt(" #n ")" ::: "memory")
#define PG8_BAR __builtin_amdgcn_s_barrier()
#define PG8_SCHED __builtin_amdgcn_sched_barrier(0)
    Unit cur, nxt; int ui = 0;
    if (!S.next(0, cur)) return;
    f32x4 acc[2][2][4][2];
#pragma unroll
    for (int a = 0; a < 2; ++a)
#pragma unroll
        for (int b = 0; b < 2; ++b)
#pragma unroll
            for (int m = 0; m < 4; ++m)
#pragma unroll
                for (int n = 0; n < 2; ++n) acc[a][b][m][n] = (f32x4){0.f, 0.f, 0.f, 0.f};
    bf16x8 At[4][2], B0[2][2], B1[2][2];
    const char* cA = (const char*)g.A + (g.uoff ? (size_t)cur.aoff : (size_t)cur.pm * tstepA); const char* cB = (const char*)g.Bt + (g.uoff ? (size_t)cur.boff : (size_t)cur.pn * tstepB);
    S.a_ready(cur);
    if constexpr (SP2) {
        PG8_STAGE(PG8_SB(0, 0), cB, voffB); PG8_STAGE(PG8_SB(0, 1), cB + hstepB, voffB); PG8_STAGE(PG8_SA(0, 0), cA, voffA); PG8_STAGE(PG8_SA(0, 1), cA + hstepA, voffA);
        if (wr == 1) PG8_BAR;
        PG8_WAIT_V(2); PG8_BAR;
        PG8_STAGE(PG8_SB(1, 0), cB + kstepB, voffB); PG8_STAGE(PG8_SA(1, 0), cA + kstepA, voffA); PG8_STAGE(PG8_SB(1, 1), cB + hstepB + kstepB, voffB);
        PG8_WAIT_V(6); PG8_BAR;
    } else {
        PG8_STAGE(PG8_SB(0, 0), cB, voffB); PG8_STAGE(PG8_SA(0, 0), cA, voffA); PG8_STAGE(PG8_SB(0, 1), cB + hstepB, voffB); PG8_STAGE(PG8_SA(0, 1), cA + hstepA, voffA);
        if (wr == 1) PG8_BAR;
        PG8_WAIT_V(4); PG8_BAR;
        PG8_STAGE(PG8_SB(1, 0), cB + kstepB, voffB); PG8_STAGE(PG8_SA(1, 0), cA + kstepA, voffA); PG8_STAGE(PG8_SB(1, 1), cB + hstepB + kstepB, voffB);
        PG8_WAIT_V(6); PG8_BAR;
    }
    for (;;) {
        const bool has_next = S.next(ui + 1, nxt);
        const char* nA = has_next ? (const char*)g.A + (g.uoff ? (size_t)nxt.aoff : (size_t)nxt.pm * tstepA) : cA; const char* nB = has_next ? (const char*)g.Bt + (g.uoff ? (size_t)nxt.boff : (size_t)nxt.pn * tstepB) : cB;
#pragma unroll 1
        for (int t = 0; t < nt; t += 2) {
            const bool last = (t == nt - 2);
            const char* a1 = cA + (size_t)(t + 1) * kstepA;
            const char* a2 = last ? nA : cA + (size_t)(t + 2) * kstepA; const char* b2 = last ? nB : cB + (size_t)(t + 2) * kstepB;
            const char* a3 = a2 + kstepA; const char* b3 = b2 + kstepB;
            if (last && has_next) S.a_ready(nxt);
            if constexpr (Epi::KHOOK) { if (t == Epi::KH1 || t == Epi::KH2) E.khook(acc, t, wr); }
            if constexpr (SP2) {
            PG8_LDB(B0, 0, 0); PG8_LDB(B1, 0, 1); PG8_SCHED; PG8_LDA(At, 0, 0); PG8_STAGE(PG8_SA(1, 1), a1 + hstepA, voffA);
            PG8_WAIT_V(8); PG8_WAIT_L(0); PG8_BAR; PG8_MMA(0, 0, At, B0); PG8_MMA(0, 1, At, B1); PG8_BAR; PG8_SCHED;
            PG8_LDA(At, 0, 1); PG8_STAGE(PG8_SB(0, 0), b2, voffB); PG8_STAGE(PG8_SB(0, 1), b2 + hstepB, voffB); PG8_STAGE(PG8_SA(0, 0), a2, voffA);
            PG8_WAIT_V(8); PG8_WAIT_L(0); PG8_BAR; PG8_MMA(1, 0, At, B0); PG8_MMA(1, 1, At, B1); PG8_BAR; PG8_SCHED;
            PG8_LDB(B0, 1, 0); PG8_LDB(B1, 1, 1); PG8_SCHED; PG8_LDA(At, 1, 0); PG8_STAGE(PG8_SA(0, 1), a2 + hstepA, voffA);
            PG8_WAIT_V(8); PG8_WAIT_L(0); PG8_BAR; PG8_MMA(0, 0, At, B0); PG8_MMA(0, 1, At, B1); PG8_BAR; PG8_SCHED;
            PG8_LDA(At, 1, 1); PG8_STAGE(PG8_SB(1, 0), b3, voffB); PG8_STAGE(PG8_SB(1, 1), b3 + hstepB, voffB); PG8_STAGE(PG8_SA(1, 0), a3, voffA);
            PG8_WAIT_V(8); PG8_WAIT_L(0); PG8_BAR; PG8_MMA(1, 0, At, B0); PG8_MMA(1, 1, At, B1); PG8_BAR; PG8_SCHED;
            } else {
            PG8_LDB(B0, 0, 0); PG8_SCHED; PG8_LDA(At, 0, 0); PG8_STAGE(PG8_SA(1, 1), a1 + hstepA, voffA);
            PG8_WAIT_L(8); PG8_BAR; PG8_WAIT_L(0); PG8_MMA(0, 0, At, B0); PG8_BAR; PG8_SCHED;
            PG8_LDB(B1, 0, 1); PG8_STAGE(PG8_SB(0, 0), b2, voffB);
            PG8_BAR; PG8_WAIT_L(0); PG8_MMA(0, 1, At, B1); PG8_BAR;
            PG8_LDA(At, 0, 1); PG8_STAGE(PG8_SA(0, 0), a2, voffA);
            PG8_BAR; PG8_WAIT_L(0); PG8_MMA(1, 0, At, B0); PG8_BAR; PG8_SCHED;
            PG8_STAGE(PG8_SB(0, 1), b2 + hstepB, voffB);
            PG8_WAIT_V(6); PG8_BAR; PG8_MMA(1, 1, At, B1); PG8_BAR;
            PG8_LDB(B0, 1, 0); PG8_SCHED; PG8_LDA(At, 1, 0); PG8_STAGE(PG8_SA(0, 1), a2 + hstepA, voffA);
            PG8_WAIT_L(8); PG8_BAR; PG8_WAIT_L(0); PG8_MMA(0, 0, At, B0); PG8_BAR; PG8_SCHED;
            PG8_LDB(B1, 1, 1); PG8_STAGE(PG8_SB(1, 0), b3, voffB);
            PG8_BAR; PG8_WAIT_L(0); PG8_MMA(0, 1, At, B1); PG8_BAR;
            PG8_LDA(At, 1, 1); PG8_STAGE(PG8_SA(1, 0), a3, voffA);
            PG8_BAR; PG8_WAIT_L(0); PG8_MMA(1, 0, At, B0); PG8_BAR; PG8_SCHED;
            PG8_STAGE(PG8_SB(1, 1), b3 + hstepB, voffB);
            PG8_WAIT_V(6); PG8_BAR; PG8_MMA(1, 1, At, B1); PG8_BAR;
            }
        }
        if constexpr (ALIGN_EPI) { if (wr == 0) PG8_BAR; }
        if constexpr (!Epi::AFTER_DRAIN) { E(acc, cur, wr, wc, fr, fq); S.done(cur); }
        if (!has_next) break;
#pragma unroll
        for (int a = 0; a < 2; ++a)
#pragma unroll
            for (int b = 0; b < 2; ++b)
#pragma unroll
                for (int m = 0; m < 4; ++m)
#pragma unroll
                    for (int n = 0; n < 2; ++n) acc[a][b][m][n] = (f32x4){0.f, 0.f, 0.f, 0.f};
        cur = nxt; cA = nA; cB = nB; ++ui;
        if constexpr (ALIGN_EPI) { if (wr == 1) PG8_BAR; }
    }
    PG8_WAIT_V(0);
    if constexpr (!ALIGN_EPI) { if (wr == 0) PG8_BAR; }
    PG8_BAR;
    if constexpr (Epi::AFTER_DRAIN) { E.fused(acc, cur, wr, wc, fr, fq, lds, wid, lane); S.done(cur); }
#undef PG8_SA
#undef PG8_SB
#undef PG8_STAGE
#undef PG8_LDA
#undef PG8_LDB
#undef PG8_MMA
#undef PG8_WAIT_V
#undef PG8_WAIT_L
#undef PG8_BAR
#undef PG8_SCHED
}
}

namespace pg8 {
typedef float f32x8 __attribute__((ext_vector_type(8)));
typedef unsigned u32x2 __attribute__((ext_vector_type(2)));
typedef __bf16 bf16x8v __attribute__((ext_vector_type(8)));
__device__ __forceinline__ u32x4 pack8(f32x4 a, f32x4 b) { const f32x8 v = __builtin_shufflevector(a, b, 0, 1, 2, 3, 4, 5, 6, 7); return __builtin_bit_cast(u32x4, __builtin_convertvector(v, bf16x8v)); }
struct EpiF32 {
    static constexpr bool PERM = false, AFTER_DRAIN = false, KHOOK = false; float* O; int ldc, ncols;
    __device__ __forceinline__ void operator()(const f32x4 (&acc)[2][2][4][2], const Unit& u, int wr, int wc, int, int) const {
        int lane_; asm volatile("v_mbcnt_lo_u32_b32 %0, -1, 0\n\tv_mbcnt_hi_u32_b32 %0, -1, %0" : "=v"(lane_)); const int fr = lane_ & 15, fq = lane_ >> 4;
        const int row0 = u.pm * BM + wr * 64 + fr, col0 = u.pn * BM + wc * 32 + 4 * fq;
#pragma unroll
        for (int ai = 0; ai < 2; ++ai)
#pragma unroll
            for (int m = 0; m < 4; ++m) { float* rowp = O + (size_t)(row0 + ai * HALF + m * 16) * ldc;
#pragma unroll
                for (int bj = 0; bj < 2; ++bj)
#pragma unroll
                    for (int n = 0; n < 2; ++n) { const int col = col0 + bj * HALF + n * 16; if (col < ncols) *(f32x4*)(rowp + col) = acc[ai][bj][m][n]; } }
    }
};
struct EpiBf16s {
    static constexpr bool PERM = true, AFTER_DRAIN = false, KHOOK = false; bf16_t* O; int ldo, ntn; const float* roww; const float* colscale; const __attribute__((address_space(3))) int* etab = nullptr;
    __device__ __forceinline__ void operator()(const f32x4 (&acc)[2][2][4][2], const Unit& u, int wr, int wc, int, int) const {
        int lane_; asm volatile("v_mbcnt_lo_u32_b32 %0, -1, 0\n\tv_mbcnt_hi_u32_b32 %0, -1, %0" : "=v"(lane_)); const int fr = lane_ & 15, fq = lane_ >> 4;
        const int row0 = u.pm * BM + wr * 64 + fr, col0 = (u.pn % ntn) * BM + wc * 32 + 8 * fq;
        const float* roww = this->roww; if (etab) { const int e = etab[32 + u.pm]; roww += (long)e * 16384 - etab[e]; }
        f32x4 cs[2][2];
#pragma unroll
        for (int bj = 0; bj < 2; ++bj)
#pragma unroll
            for (int n = 0; n < 2; ++n) cs[bj][n] = colscale ? *(const f32x4*)(colscale + col0 + bj * HALF + 4 * n) : (f32x4){1.f, 1.f, 1.f, 1.f};
#pragma unroll
        for (int ai = 0; ai < 2; ++ai)
#pragma unroll
            for (int m = 0; m < 4; ++m) { const int row = row0 + ai * HALF + m * 16; const float rs = roww ? roww[row] : 1.f; bf16_t* rowp = O + (size_t)row * ldo + col0;
#pragma unroll
                for (int bj = 0; bj < 2; ++bj) { const f32x4 v0 = acc[ai][bj][m][0] * cs[bj][0] * rs, v1 = acc[ai][bj][m][1] * cs[bj][1] * rs;
                    const u32x4 w = pack8(v0, v1);
                    *(u32x4*)(rowp + bj * HALF) = w; } }
    }
};
__device__ __forceinline__ float silu_mul(float g, float u) { return g * __builtin_amdgcn_rcpf(1.0f + __builtin_amdgcn_exp2f(-1.4426950408889634f * g)) * u; }
struct EpiSwiGLU {
    static constexpr bool PERM = true, AFTER_DRAIN = false, KHOOK = false; bf16_t* O; int ldo, ntn;
    __device__ __forceinline__ void operator()(const f32x4 (&acc)[2][2][4][2], const Unit& u, int wr, int wc, int, int) const {
        int lane_; asm volatile("v_mbcnt_lo_u32_b32 %0, -1, 0\n\tv_mbcnt_hi_u32_b32 %0, -1, %0" : "=v"(lane_)); const int fr = lane_ & 15, fq = lane_ >> 4;
        const int row0 = u.pm * BM + wr * 64 + fr, f0 = (u.pn % ntn) * HALF + wc * 32 + 8 * fq;
#pragma unroll
        for (int ai = 0; ai < 2; ++ai)
#pragma unroll
            for (int m = 0; m < 4; ++m) { const f32x4 g0 = acc[ai][0][m][0], g1 = acc[ai][0][m][1], u0 = acc[ai][1][m][0], u1 = acc[ai][1][m][1];
                const f32x4 h0 = {silu_mul(g0[0], u0[0]), silu_mul(g0[1], u0[1]), silu_mul(g0[2], u0[2]), silu_mul(g0[3], u0[3])}, h1 = {silu_mul(g1[0], u1[0]), silu_mul(g1[1], u1[1]), silu_mul(g1[2], u1[2]), silu_mul(g1[3], u1[3])};
                const u32x4 w = pack8(h0, h1);
                *(u32x4*)(O + (size_t)(row0 + ai * HALF + m * 16) * ldo + f0) = w; }
    }
};
__device__ __forceinline__ float clamp8(float v) { float r; asm("v_max_f32 %0, %1, %2\n\tv_min_f32 %0, %3, %0" : "=&v"(r) : "s"(-448.f), "v"(v), "s"(448.f)); return r; }
__device__ __forceinline__ u32x2 pack8_f8(f32x4 a, f32x4 b, float sc) {
    int w0 = 0, w1 = 0;
    w0 = __builtin_amdgcn_cvt_pk_fp8_f32(clamp8(a[0] * sc), clamp8(a[1] * sc), w0, false); w0 = __builtin_amdgcn_cvt_pk_fp8_f32(clamp8(a[2] * sc), clamp8(a[3] * sc), w0, true);
    w1 = __builtin_amdgcn_cvt_pk_fp8_f32(clamp8(b[0] * sc), clamp8(b[1] * sc), w1, false); w1 = __builtin_amdgcn_cvt_pk_fp8_f32(clamp8(b[2] * sc), clamp8(b[3] * sc), w1, true);
    return (u32x2){(unsigned)w0, (unsigned)w1}; }
struct EpiSwiGLU8 {
    static constexpr bool PERM = true, AFTER_DRAIN = false, KHOOK = false; unsigned char* O; int ldo, ntn;
    static __device__ __forceinline__ float sm(float g, float u) { return g * __builtin_amdgcn_rcpf(1.0f + __builtin_amdgcn_exp2f(-g)) * u; }
    __device__ __forceinline__ void operator()(const f32x4 (&acc)[2][2][4][2], const Unit& u, int wr, int wc, int, int) const {
        int lane_; asm volatile("v_mbcnt_lo_u32_b32 %0, -1, 0\n\tv_mbcnt_hi_u32_b32 %0, -1, %0" : "=v"(lane_)); const int fr = lane_ & 15, fq = lane_ >> 4;
        const int row0 = u.pm * BM + wr * 64 + fr, f0 = (u.pn % ntn) * HALF + wc * 32 + 8 * fq;
#pragma unroll
        for (int ai = 0; ai < 2; ++ai)
#pragma unroll
            for (int m = 0; m < 4; ++m) { const f32x4 g0 = acc[ai][0][m][0], g1 = acc[ai][0][m][1], u0 = acc[ai][1][m][0], u1 = acc[ai][1][m][1];
                const f32x4 e0 = {__builtin_amdgcn_exp2f(-g0[0]), __builtin_amdgcn_exp2f(-g0[1]), __builtin_amdgcn_exp2f(-g0[2]), __builtin_amdgcn_exp2f(-g0[3])}, e1 = {__builtin_amdgcn_exp2f(-g1[0]), __builtin_amdgcn_exp2f(-g1[1]), __builtin_amdgcn_exp2f(-g1[2]), __builtin_amdgcn_exp2f(-g1[3])};
                const f32x4 d0 = e0 + 1.0f, d1 = e1 + 1.0f;
                const f32x4 r0 = {__builtin_amdgcn_rcpf(d0[0]), __builtin_amdgcn_rcpf(d0[1]), __builtin_amdgcn_rcpf(d0[2]), __builtin_amdgcn_rcpf(d0[3])}, r1 = {__builtin_amdgcn_rcpf(d1[0]), __builtin_amdgcn_rcpf(d1[1]), __builtin_amdgcn_rcpf(d1[2]), __builtin_amdgcn_rcpf(d1[3])};
                const f32x4 h0 = (g0 * u0) * r0, h1 = (g1 * u1) * r1;
                int w0 = 0, w1 = 0;
                w0 = __builtin_amdgcn_cvt_pk_fp8_f32(clamp8(h0[0]), clamp8(h0[1]), w0, false); w0 = __builtin_amdgcn_cvt_pk_fp8_f32(clamp8(h0[2]), clamp8(h0[3]), w0, true);
                w1 = __builtin_amdgcn_cvt_pk_fp8_f32(clamp8(h1[0]), clamp8(h1[1]), w1, false); w1 = __builtin_amdgcn_cvt_pk_fp8_f32(clamp8(h1[2]), clamp8(h1[3]), w1, true);
                *(u32x2*)(O + (size_t)(row0 + ai * HALF + m * 16) * ldo + f0) = (u32x2){(unsigned)w0, (unsigned)w1}; }
    }
};
struct EpiWo {
    static constexpr bool PERM = true, AFTER_DRAIN = false, KHOOK = true; static constexpr int KH1 = 4, KH2 = 8;
    bf16_t* O; int ldo; const __attribute__((address_space(3))) float* rt;
    __device__ __forceinline__ void scale(f32x4 (&acc)[2][2][4][2], int which, int wr) const {
        int lane_; asm volatile("v_mbcnt_lo_u32_b32 %0, -1, 0\n\tv_mbcnt_hi_u32_b32 %0, -1, %0" : "=v"(lane_)); const int fr = lane_ & 15;
#pragma unroll
        for (int ai = 0; ai < 2; ++ai)
#pragma unroll
            for (int m = 0; m < 4; ++m) { const float s = rt[4 * (wr * 64 + ai * HALF + m * 16 + fr) + which];
#pragma unroll
                for (int bj = 0; bj < 2; ++bj)
#pragma unroll
                    for (int n = 0; n < 2; ++n) acc[ai][bj][m][n] *= s; }
    }
    __device__ __forceinline__ void khook(f32x4 (&acc)[2][2][4][2], int t, int wr) const { scale(acc, t == KH1 ? 0 : 1, wr); }
    __device__ __forceinline__ void operator()(f32x4 (&acc)[2][2][4][2], const Unit& u, int wr, int wc, int, int) const {
        int lane_; asm volatile("v_mbcnt_lo_u32_b32 %0, -1, 0\n\tv_mbcnt_hi_u32_b32 %0, -1, %0" : "=v"(lane_)); const int fr = lane_ & 15, fq = lane_ >> 4;
        const int row0 = u.pm * BM + wr * 64 + fr, col0 = u.pn * BM + wc * 32 + 8 * fq;
#pragma unroll
        for (int ai = 0; ai < 2; ++ai)
#pragma unroll
            for (int m = 0; m < 4; ++m) { const int row = row0 + ai * HALF + m * 16; const float rs = rt[4 * (wr * 64 + ai * HALF + m * 16 + fr) + 2]; bf16_t* rowp = O + (size_t)row * ldo + col0;
#pragma unroll
                for (int bj = 0; bj < 2; ++bj) { const f32x4 v0 = acc[ai][bj][m][0] * rs, v1 = acc[ai][bj][m][1] * rs; *(u32x4*)(rowp + bj * HALF) = pack8(v0, v1); } }
    }
};
struct EpiMlaUp {
    static constexpr bool PERM = true, AFTER_DRAIN = false, KHOOK = false; bf16_t* QB; bf16_t* KVB;
    __device__ __forceinline__ void operator()(const f32x4 (&acc)[2][2][4][2], const Unit& u, int wr, int wc, int, int) const {
        int lane_; asm volatile("v_mbcnt_lo_u32_b32 %0, -1, 0\n\tv_mbcnt_hi_u32_b32 %0, -1, %0" : "=v"(lane_)); const int fr = lane_ & 15, fq = lane_ >> 4;
        const int row0 = u.pm * BM + wr * 64 + fr;
#pragma unroll
        for (int bj = 0; bj < 2; ++bj) {
            const int g = 8 * u.pn + 4 * bj + wc;
            if (g >= 28) continue;
            bf16_t* base = g < 12 ? QB + 32 * g + 8 * fq : KVB + 32 * g - 384 + 8 * fq; const int ld = g < 12 ? 384 : 512;
#pragma unroll
            for (int ai = 0; ai < 2; ++ai)
#pragma unroll
                for (int m = 0; m < 4; ++m) { const int row = row0 + ai * HALF + m * 16; const f32x4 v0 = acc[ai][bj][m][0], v1 = acc[ai][bj][m][1];
                    const u32x4 w = pack8(v0, v1);
                    *(u32x4*)(base + (size_t)row * ld) = w; }
        }
    }
};
struct EpiF8s {
    static constexpr bool PERM = true, AFTER_DRAIN = false, KHOOK = false; unsigned char* O; int ntn; const float* roww; const __attribute__((address_space(3))) int* etab; float sc;
    __device__ __forceinline__ void operator()(const f32x4 (&acc)[2][2][4][2], const Unit& u, int wr, int wc, int, int) const {
        int lane_; asm volatile("v_mbcnt_lo_u32_b32 %0, -1, 0\n\tv_mbcnt_hi_u32_b32 %0, -1, %0" : "=v"(lane_)); const int fr = lane_ & 15, fq = lane_ >> 4;
        const int row0 = u.pm * BM + wr * 64 + fr, col0 = (u.pn % ntn) * BM + wc * 32 + 8 * fq;
        const float* rw = roww; { const int e = etab[32 + u.pm]; rw += (long)e * 16384 - etab[e]; }
#pragma unroll
        for (int ai = 0; ai < 2; ++ai)
#pragma unroll
            for (int m = 0; m < 4; ++m) { const int row = row0 + ai * HALF + m * 16; const float rs = rw[row] * sc; unsigned char* rowp = O + (size_t)row * 1024 + col0;
#pragma unroll
                for (int bj = 0; bj < 2; ++bj) *(u32x2*)(rowp + bj * HALF) = pack8_f8(acc[ai][bj][m][0], acc[ai][bj][m][1], rs); }
    }
};
struct EpiPart {
    static constexpr bool PERM = true, AFTER_DRAIN = false, KHOOK = false; bf16_t* O; const float* roww; const __attribute__((address_space(3))) int* etab;
    __device__ __forceinline__ void operator()(const f32x4 (&acc)[2][2][4][2], const Unit& u, int wr, int wc, int, int) const {
        int lane_; asm volatile("v_mbcnt_lo_u32_b32 %0, -1, 0\n\tv_mbcnt_hi_u32_b32 %0, -1, %0" : "=v"(lane_)); const int fr = lane_ & 15, fq = lane_ >> 4;
        const int pm = u.pm & 0xffff, s = u.pm >> 16, row0 = wr * 64 + fr, col0 = u.pn * BM + wc * 32 + 8 * fq;
        const float* roww = this->roww; { const int e = etab[32 + pm]; roww += (long)e * 16384 - etab[e]; }
#pragma unroll
        for (int ai = 0; ai < 2; ++ai)
#pragma unroll
            for (int m = 0; m < 4; ++m) { const int r = row0 + ai * HALF + m * 16; const float rs = roww[pm * 256 + r]; bf16_t* rowp = O + ((size_t)(s * 8 + (pm - 128)) * 256 + r) * 1024 + col0;
#pragma unroll
                for (int bj = 0; bj < 2; ++bj) { const f32x4 v0 = acc[ai][bj][m][0] * rs, v1 = acc[ai][bj][m][1] * rs; *(u32x4*)(rowp + bj * HALF) = pack8(v0, v1); } }
    }
};
}

#define GAS __attribute__((address_space(1)))
#define LAS __attribute__((address_space(3)))
typedef unsigned short bf16;
typedef unsigned v4u __attribute__((ext_vector_type(4)));
typedef float f32x4 __attribute__((ext_vector_type(4)));
typedef short bf16x8 __attribute__((ext_vector_type(8)));
typedef GAS unsigned gu32;
typedef GAS unsigned long long gu64;
#define RLX_AGENT __ATOMIC_RELAXED, __HIP_MEMORY_SCOPE_AGENT
#define LDS_WAIT() asm volatile("s_waitcnt lgkmcnt(0)" ::: "memory")
#define VM_WAIT() asm volatile("s_waitcnt vmcnt(0)" ::: "memory")
__device__ __forceinline__ unsigned long long rt() { return __builtin_amdgcn_s_memrealtime(); }
__device__ __forceinline__ unsigned f2bf(float f) { unsigned u = __builtin_bit_cast(unsigned, f); return (u + 0x7fffu + ((u >> 16) & 1u)) >> 16; }
__device__ __forceinline__ unsigned pk2(float lo, float hi) { return f2bf(lo) | (f2bf(hi) << 16); }
#define XB_TMO      128
#define XB_XCNT(j)  (256  + 64 * (j))
#define XB_XSUB(j)  (1280 + 64 * (j))
#define XB_XGEN(j)  (2304 + 64 * (j))
#define XB_TOP      3328
#define XB_TOPGEN   3392
#define XCD_BAR_WORDS 3456
#define XB_SPIN_CAP (1u << 18)

__device__ __forceinline__ unsigned xb_ld(unsigned* p)              { return __hip_atomic_load(p, __ATOMIC_RELAXED, __HIP_MEMORY_SCOPE_AGENT); }
__device__ __forceinline__ unsigned xb_add(unsigned* p, unsigned v) { return __hip_atomic_fetch_add(p, v, __ATOMIC_RELAXED, __HIP_MEMORY_SCOPE_AGENT); }
__device__ __forceinline__ unsigned xb_xcc_id() { return (unsigned)__builtin_amdgcn_s_getreg((3 << 11) | 20) & 0xFu; }
#define XB_SPIN(cond, bar) do { unsigned _sp = 0; while (cond) { __builtin_amdgcn_s_sleep(1); \
    if ((++_sp & 255u) == 0u) { if (xb_ld(&(bar)[XB_TMO])) break; if (_sp > XB_SPIN_CAP) { atomicAdd(&(bar)[XB_TMO], 1u); break; } } } } while (0)

struct XcdBarrier {
    unsigned* bar; unsigned x;
    volatile LAS unsigned* st;
};

__device__ __forceinline__ XcdBarrier xcd_barrier_post(unsigned* bar, volatile LAS unsigned* st) {
    XcdBarrier b; b.bar = bar; b.x = xb_xcc_id(); b.st = st;
    if (threadIdx.x == 0) st[3] = xb_add(&bar[XB_XCNT(b.x)], 1u);
    return b;
}
__device__ __forceinline__ void xcd_barrier_complete(unsigned* bar, unsigned x, unsigned& nloc, unsigned& nx) {
    const unsigned G = gridDim.x * gridDim.y * gridDim.z;
    unsigned sum, cnt, mine, sp = 0u;
    for (;;) {
        sum = 0u; cnt = 0u; mine = 0u;
#pragma unroll
        for (unsigned j = 0; j < 16; ++j) { const unsigned c = xb_ld(&bar[XB_XCNT(j)]); sum += c; cnt += (c > 0u) ? 1u : 0u; mine = (j == x) ? c : mine; }
        if (sum == G) break;
        __builtin_amdgcn_s_sleep(1);
        if ((++sp & 255u) == 0u) { if (xb_ld(&bar[XB_TMO])) break; if (sp > XB_SPIN_CAP) { atomicAdd(&bar[XB_TMO], 1u); break; } }
    }
    nloc = mine > 0u ? mine : 1u; nx = cnt > 0u ? cnt : 1u;
}
__device__ __forceinline__ unsigned xcd_census_uniform(unsigned* bar) {
    const unsigned G = gridDim.x * gridDim.y * gridDim.z; unsigned ok = (G % 8u) == 0u ? 1u : 0u;
#pragma unroll
    for (unsigned j = 0; j < 8; ++j) ok &= (xb_ld(&bar[XB_XCNT(j)]) == G / 8u) ? 1u : 0u;
    return ok;
}

__device__ __forceinline__ void xcd_barrier(const XcdBarrier& b) {
    asm volatile("s_waitcnt vmcnt(0)" ::: "memory");
    __syncthreads();
    if (threadIdx.x == 0) {
        unsigned* bar = b.bar;
        __builtin_amdgcn_s_waitcnt(0);
        unsigned nloc = b.st[0], nx = b.st[1];
        if (nloc == 0u) { xcd_barrier_complete(bar, b.x, nloc, nx); b.st[0] = nloc; b.st[1] = nx; b.st[2] = xcd_census_uniform(bar); }
        const unsigned old = xb_add(&bar[XB_XSUB(b.x)], 1u);
        const unsigned gen = old / nloc;
        if (old + 1u == (gen + 1u) * nloc) {
            __builtin_amdgcn_fence(__ATOMIC_RELEASE, "agent");
            asm volatile("s_waitcnt vmcnt(0)" ::: "memory");
            const unsigned og = xb_add(&bar[XB_TOP], 1u);
            const unsigned tg = og / nx;
            if (og + 1u == (tg + 1u) * nx) xb_add(&bar[XB_TOPGEN], 1u);
            else XB_SPIN(xb_ld(&bar[XB_TOPGEN]) == tg, bar);
            __builtin_amdgcn_fence(__ATOMIC_ACQUIRE, "agent");
            xb_add(&bar[XB_XGEN(b.x)], 1u);
            asm volatile("s_waitcnt vmcnt(0)" ::: "memory");
        } else {
            XB_SPIN(xb_ld(&bar[XB_XGEN(b.x)]) == gen, bar);
            __builtin_amdgcn_fence(__ATOMIC_ACQUIRE, "agent");
            asm volatile("s_waitcnt vmcnt(0)" ::: "memory");
        }
    }
    __syncthreads();
}

__device__ __forceinline__ void xcd_barrier_local(const XcdBarrier& b) {
    asm volatile("s_waitcnt vmcnt(0)" ::: "memory");
    __syncthreads();
    if (threadIdx.x == 0) {
        unsigned* bar = b.bar;
        __builtin_amdgcn_s_waitcnt(0);
        const unsigned nloc = b.st[0];
        const unsigned old = xb_add(&bar[XB_XSUB(b.x)], 1u);
        const unsigned gen = old / nloc;
        if (old + 1u == (gen + 1u) * nloc) xb_add(&bar[XB_XGEN(b.x)], 1u);
        else XB_SPIN(xb_ld(&bar[XB_XGEN(b.x)]) == gen, bar);
        __builtin_amdgcn_fence(__ATOMIC_ACQUIRE, "agent");
        asm volatile("s_waitcnt vmcnt(0)" ::: "memory");
    }
    __syncthreads();
}

#define DI __device__ __forceinline__
constexpr int DM = 1024, NB = 4, SQ = 4096, NT = NB * SQ, NIN = 2232, NINP = 2304;
constexpr int O_AQ = 0, O_AK = 256, O_AV = 384, O_BCQ = 512, O_BCKV = 768, O_BKR = 896, O_CQ = 928, O_CKC = 1440, O_CVC = 1568,
              O_CKS = 1696, O_CVS = 1824, O_CKW = 1952, O_CVW = 2080, O_CG = 2208;
constexpr int NCMP = 255, DFF = 4096, NEXP = 8, DFE = 3584, MOE_ROWS = 32768 + 8 * 256;
constexpr float EPS = 1e-6f;
constexpr int NWAVES = 8;
constexpr int LDS_BYTES = 147456, RING_BYTES = 131072, LDSCTL_OFF = RING_BYTES, MISC_OFF = RING_BYTES + 320, TAB_OFF = RING_BYTES + 1024;
constexpr size_t MiB = 1u << 20;
constexpr size_t WS_CTL = 0, CTL_ZERO_BYTES = 128 * 1024;
constexpr size_t WS_WIN = 1 * MiB, WS_WUP = 10 * MiB, WS_WO = 12 * MiB, WS_WGU = 16 * MiB, WS_WD = 32 * MiB, WS_ROPE = 40 * MiB;
constexpr size_t WS_TOKE = 42 * MiB, WS_TOKP = WS_TOKE + 128 * 1024, WS_TOKW = WS_TOKP + 128 * 1024, WS_ROWTOK = WS_TOKW + 128 * 1024, WS_ROWW = WS_ROWTOK + 256 * 1024;
constexpr size_t WIN_L = (size_t)NINP * 1024 * 2, WUP_L = (size_t)1024 * 384 * 2, WO_L = (size_t)1024 * 1024 * 2;
constexpr size_t WS_PROJ = 45 * MiB, WS_CQKV = 117 * MiB, WS_QB = 129 * MiB, WS_KVB = 141 * MiB, WS_KR = 157 * MiB, WS_KC = 158 * MiB, WS_VC = 158 * MiB + 512 * 1024, WS_SELM = 159 * MiB,
                 WS_OA = 160 * MiB, WS_OB = 168 * MiB, WS_OCMP = 176 * MiB, WS_OSLC = 192 * MiB, WS_OWIN = 208 * MiB, WS_XN = 225 * MiB, WS_MIXED = 257 * MiB, WS_MOUT = 289 * MiB;
constexpr size_t WS_HIDB = 45 * MiB, WS_FOUT = 321 * MiB;
constexpr size_t WS_WC1 = 192 * MiB, WC1_L = (size_t)512 * 2048 * 2, WS_HIDP = 196 * MiB, WS_CBIAS = 204 * MiB;
constexpr size_t WS_PART = 172 * MiB;
constexpr int F8_PAIR = 4;
constexpr int F8_XN = 2, F8_WGU = 6, F8_HID = 3, F8_WD = 7;
constexpr int F8S_GU = (127 - (F8_WGU + F8_XN) / 2) * 257, F8S_D = (127 - (F8_WD + F8_HID) / 2) * 257;
static_assert((F8_WGU + F8_XN) % 2 == 0 && (F8_WD + F8_HID) % 2 == 0, "even scale sums");
constexpr size_t WS_MGU = 378 * MiB, WS_AG = 45 * MiB, WS_ROWWE = 43 * MiB + 512 * 1024, WS_SSQ = 44 * MiB;
constexpr size_t WS_HIDM = 225 * MiB, WS_MD = 350 * MiB, WS_PAIR = 101 * MiB, WS_END = 463 * MiB;
constexpr int NCH_F = 3 * 2048 / 32, NCH_PREP = 320;
constexpr int CONV_CHUNK = 32, NCH_GU = 2 * NEXP * 16 * (DFE / 32) / CONV_CHUNK, NCH_D = NEXP * (DFE / 64) * 32 / CONV_CHUNK;
constexpr int CW_BAR = 4096, CW_Q = 8192, CW_Q2 = 12288, CW_CNT = 16384, CW_QX = 17408;
constexpr int PH_PRO = 0, L0_BASE = 1, L1_BASE = 10, NPH = 19;
enum { J_INPROJ = 0, J_PREP = 1, J_MLAUP = 2, J_ATTN = 3, J_WO = 4, J_RESN = 5, J_F1 = 6, J_F2 = 7, J_F3 = 8 };

DI float bflo(unsigned w) { return __uint_as_float(w << 16); }
DI float bfhi(unsigned w) { return __uint_as_float(w & 0xffff0000u); }
DI float bf1(bf16 v) { return __uint_as_float((unsigned)v << 16); }
DI float shx(float v, int m, int lane) { return __int_as_float(__builtin_amdgcn_ds_bpermute((lane ^ m) << 2, __float_as_int(v))); }
DI unsigned shxu(unsigned v, int m, int lane) { return (unsigned)__builtin_amdgcn_ds_bpermute((lane ^ m) << 2, (int)v); }
DI float wave_sum(float v, int lane) {
#pragma unroll
    for (int o = 32; o > 0; o >>= 1) v += shx(v, o, lane);
    return v; }
DI float wave_max(float v, int lane) {
#pragma unroll
    for (int o = 32; o > 0; o >>= 1) v = fmaxf(v, shx(v, o, lane));
    return v; }
DI int q_pop(gu32* ctr, int lane) { unsigned v = 0; if (lane == 0) v = __hip_atomic_fetch_add(ctr, 1u, RLX_AGENT); return (int)__builtin_amdgcn_readfirstlane(v); }
DI float rope_inv(int i) { return exp2f(-(float)i * 0.83048202372184059f); }

DI int conv_rowmap(int mode, int row_off, int n) { return mode == 0 ? row_off + n : row_off + ((n >> 7) << 8) + (n & 127); }
DI void conv_load(const float* W, int N, int item, int lane, f32x4 (&v)[8]) {
    const int nblk = (N + 31) / 32, kb = item / nblk, nb = item % nblk, k0 = 64 * kb, n0 = 32 * nb, c4 = lane & 7, kr = lane >> 3; const bool nv = n0 + 4 * c4 < N;
#pragma unroll
    for (int j = 0; j < 8; ++j) v[j] = nv ? *(const f32x4*)(W + (size_t)(k0 + 8 * j + kr) * N + n0 + 4 * c4) : (f32x4){0.f, 0.f, 0.f, 0.f};
}
DI int pk4_f8(float a, float b, float c, float d, float sc) { int w = 0; w = __builtin_amdgcn_cvt_pk_fp8_f32(__builtin_amdgcn_fmed3f(a * sc, -448.f, 448.f), __builtin_amdgcn_fmed3f(b * sc, -448.f, 448.f), w, false);
    return __builtin_amdgcn_cvt_pk_fp8_f32(__builtin_amdgcn_fmed3f(c * sc, -448.f, 448.f), __builtin_amdgcn_fmed3f(d * sc, -448.f, 448.f), w, true); }
template <bool F8 = false>
DI void conv_finish(const f32x4 (&v)[8], int N, bf16* WT, int ldk, int kofs, int mode, int row_off, LAS float* scr, int item, int lane, float f8sc = 1.f) {
    const int nblk = (N + 31) / 32, kb = item / nblk, nb = item % nblk, k0 = 64 * kb, n0 = 32 * nb;
    { const int c4 = lane & 7, kr = lane >> 3;
#pragma unroll
      for (int j = 0; j < 8; ++j) { LAS float* d = scr + (8 * j + kr) * 33 + 4 * c4; d[0] = v[j][0]; d[1] = v[j][1]; d[2] = v[j][2]; d[3] = v[j][3]; } }
    LDS_WAIT(); asm volatile("" ::: "memory");
    const int c = lane & 7;
#pragma unroll
    for (int j = 0; j < 4; ++j) { const int n = (lane >> 3) + 8 * j; const LAS float* s = scr + (8 * c) * 33 + n;
        if constexpr (F8) { const uint2 o = make_uint2((unsigned)pk4_f8(s[0 * 33], s[1 * 33], s[2 * 33], s[3 * 33], f8sc), (unsigned)pk4_f8(s[4 * 33], s[5 * 33], s[6 * 33], s[7 * 33], f8sc));
            if (n0 + n < N) *(uint2*)((unsigned char*)WT + (size_t)conv_rowmap(mode, row_off, n0 + n) * ldk + kofs + k0 + 8 * c) = o; }
        else { const v4u o = {pk2(s[0 * 33] * f8sc, s[1 * 33] * f8sc), pk2(s[2 * 33] * f8sc, s[3 * 33] * f8sc), pk2(s[4 * 33] * f8sc, s[5 * 33] * f8sc), pk2(s[6 * 33] * f8sc, s[7 * 33] * f8sc)};
            if (n0 + n < N) *(GAS v4u*)(WT + (size_t)conv_rowmap(mode, row_off, n0 + n) * ldk + kofs + k0 + 8 * c) = o; } }
    LDS_WAIT(); asm volatile("" ::: "memory");
}
DI void conv_job(const float* W, int K, int N, bf16* WT, int ldk, int kofs, int mode, int row_off, LAS float* scr, int gw, int ngw, int lane) {
    const int nitems = (K / 64) * ((N + 31) / 32);
    f32x4 va[8], vb[8];
    int it = gw; if (it < nitems) conv_load(W, N, it, lane, va);
    while (it < nitems) {
        const int i1 = it + ngw; if (i1 < nitems) conv_load(W, N, i1, lane, vb);
        conv_finish(va, N, WT, ldk, kofs, mode, row_off, scr, it, lane);
        if (i1 >= nitems) break;
        const int i2 = i1 + ngw; if (i2 < nitems) conv_load(W, N, i2, lane, va);
        conv_finish(vb, N, WT, ldk, kofs, mode, row_off, scr, i1, lane);
        it = i2;
    }
}

DI void conv_scale_rows(f32x4 (&v)[8], int item, int lane, const float* ga, const float* gb, const float* gc) {
    const int kb = item / 32, k0 = 64 * kb, kr = lane >> 3; const float* g = k0 < 256 ? ga + k0 : k0 < 512 ? gb + (k0 - 256) : gc + (k0 - 512);
#pragma unroll
    for (int j = 0; j < 8; ++j) v[j] *= g[8 * j + kr];
}
DI void conv_job_wo(const float* W, bf16* WT, const float* ga, const float* gb, const float* gc, LAS float* scr, int gw, int ngw, int lane) {
    const int nitems = 16 * 32;
    f32x4 va[8], vb[8];
    int it = gw; if (it < nitems) conv_load(W, 1024, it, lane, va);
    while (it < nitems) {
        const int i1 = it + ngw; if (i1 < nitems) conv_load(W, 1024, i1, lane, vb);
        conv_scale_rows(va, it, lane, ga, gb, gc); conv_finish(va, 1024, WT, 1024, 0, 0, 0, scr, it, lane);
        if (i1 >= nitems) break;
        const int i2 = i1 + ngw; if (i2 < nitems) conv_load(W, 1024, i2, lane, va);
        conv_scale_rows(vb, i1, lane, ga, gb, gc); conv_finish(vb, 1024, WT, 1024, 0, 0, 0, scr, i1, lane);
        it = i2;
    }
}
struct OneUnit { pg8::Unit u; DI bool next(int i, pg8::Unit& o) const { if (i > 0) return false; o.pm = __builtin_amdgcn_readfirstlane(u.pm); o.pn = __builtin_amdgcn_readfirstlane(u.pn); o.aoff = 0; o.boff = 0; return true; } DI void a_ready(const pg8::Unit&) const {} DI void done(const pg8::Unit&) const {} };

template <bool F8 = false>
DI void conv_range(const float* W, size_t wstride, int K, int N, bf16* WT, int ldk, int mode, int row_off0, int jshift, int rstride, int rsub, LAS float* scr, int it0, int step, int end, int lane, float f8sc = 1.f) {
    const int per = (K / 64) * ((N + 31) / 32), jmask = (1 << jshift) - 1;
    f32x4 va[8], vb[8];
    int it = it0; if (it < end) { const int j = it / per; conv_load(W + (size_t)j * wstride, N, it - j * per, lane, va); }
    while (it < end) {
        const int i1 = it + step; if (i1 < end) { const int j = i1 / per; conv_load(W + (size_t)j * wstride, N, i1 - j * per, lane, vb); }
        { const int j = it / per; conv_finish<F8>(va, N, WT, ldk, 0, mode, row_off0 + (j >> jshift) * rstride + (j & jmask) * rsub, scr, it - j * per, lane, f8sc); }
        if (i1 >= end) break;
        const int i2 = i1 + step; if (i2 < end) { const int j = i2 / per; conv_load(W + (size_t)j * wstride, N, i2 - j * per, lane, va); }
        { const int j = i1 / per; conv_finish<F8>(vb, N, WT, ldk, 0, mode, row_off0 + (j >> jshift) * rstride + (j & jmask) * rsub, scr, i1 - j * per, lane, f8sc); }
        it = i2;
    }
}
template <bool F8 = false>
DI void conv_four(const float* W, size_t wstride, int K, int N, bf16* WT, int ldk, int mode, int row_off0, int jshift, int rstride, int rsub, LAS float* scr, int it0, int step, int lane, float f8sc = 1.f) {
    const int per = (K / 64) * ((N + 31) / 32), jmask = (1 << jshift) - 1;
    f32x4 v0[8], v1[8], v2[8], v3[8];
    const int i0 = it0, i1 = it0 + step, i2 = it0 + 2 * step, i3 = it0 + 3 * step; const int j0 = i0 / per, j1 = i1 / per, j2 = i2 / per, j3 = i3 / per;
    conv_load(W + (size_t)j0 * wstride, N, i0 - j0 * per, lane, v0); conv_load(W + (size_t)j1 * wstride, N, i1 - j1 * per, lane, v1);
    conv_load(W + (size_t)j2 * wstride, N, i2 - j2 * per, lane, v2); conv_load(W + (size_t)j3 * wstride, N, i3 - j3 * per, lane, v3);
    conv_finish<F8>(v0, N, WT, ldk, 0, mode, row_off0 + (j0 >> jshift) * rstride + (j0 & jmask) * rsub, scr, i0 - j0 * per, lane, f8sc);
    conv_finish<F8>(v1, N, WT, ldk, 0, mode, row_off0 + (j1 >> jshift) * rstride + (j1 & jmask) * rsub, scr, i1 - j1 * per, lane, f8sc);
    conv_finish<F8>(v2, N, WT, ldk, 0, mode, row_off0 + (j2 >> jshift) * rstride + (j2 & jmask) * rsub, scr, i2 - j2 * per, lane, f8sc);
    conv_finish<F8>(v3, N, WT, ldk, 0, mode, row_off0 + (j3 >> jshift) * rstride + (j3 & jmask) * rsub, scr, i3 - j3 * per, lane, f8sc);
}
template <bool F8 = false>
DI void conv_multi(const float* W, size_t wstride, int njobs, int K, int N, bf16* WT, int ldk, int mode, int row_off0, int jshift, int rstride, int rsub, LAS float* scr, int gw, int ngw, int lane, float f8sc = 1.f) {
    conv_range<F8>(W, wstride, K, N, WT, ldk, mode, row_off0, jshift, rstride, rsub, scr, gw, ngw, (K / 64) * ((N + 31) / 32) * njobs, lane, f8sc);
}

DI void zero_rect(bf16* base, int ld, int row0, int nrows, int col0, int ncols, int gw, int ngw, int lane) {
    const v4u z = {0u, 0u, 0u, 0u};
    for (int r = gw; r < nrows; r += ngw) { v4u* p = (v4u*)(base + (size_t)(row0 + r) * ld + col0); for (int c = lane; c < ncols / 8; c += 64) p[c] = z; }
}
DI void store_bf16_row(bf16* orow, int lane, const f32x4 (&y)[4]) {
#pragma unroll
    for (int j = 0; j < 4; ++j) ((uint2*)orow)[lane + 64 * j] = make_uint2(pk2(y[j][0], y[j][1]), pk2(y[j][2], y[j][3]));
}
DI float ssq4(const f32x4 (&v)[4], int lane) { float s = 0.f;
#pragma unroll
    for (int j = 0; j < 4; ++j) s += (v[j][0] * v[j][0] + v[j][1] * v[j][1]) + (v[j][2] * v[j][2] + v[j][3] * v[j][3]);
    return wave_sum(s, lane); }
DI void xn_row(const float* xrow, const float* g, bf16* orow, int lane) {
    f32x4 v[4];
#pragma unroll
    for (int j = 0; j < 4; ++j) v[j] = ((const f32x4*)xrow)[lane + 64 * j];
    const float r = 1.0f / sqrtf(ssq4(v, lane) * (1.0f / DM) + EPS);
#pragma unroll
    for (int j = 0; j < 4; ++j) v[j] = v[j] * r * ((const f32x4*)g)[lane + 64 * j];
    store_bf16_row(orow, lane, v);
}
DI void xn_row2(const float* x0, const float* x1, const float* g, bf16* o0, bf16* o1, int lane) {
    f32x4 v[4], w[4];
#pragma unroll
    for (int j = 0; j < 4; ++j) { v[j] = ((const f32x4*)x0)[lane + 64 * j]; w[j] = ((const f32x4*)x1)[lane + 64 * j]; }
    const float r0 = 1.0f / sqrtf(ssq4(v, lane) * (1.0f / DM) + EPS), r1 = 1.0f / sqrtf(ssq4(w, lane) * (1.0f / DM) + EPS);
#pragma unroll
    for (int j = 0; j < 4; ++j) { const f32x4 gg = ((const f32x4*)g)[lane + 64 * j]; v[j] = v[j] * r0 * gg; w[j] = w[j] * r1 * gg; }
    store_bf16_row(o0, lane, v); if (o1 != o0) store_bf16_row(o1, lane, w);
}
DI void add_post(f32x4 (&xv)[4], const uint2 (&w)[4], const float* gpost, int lane) {
    f32x4 mp[4];
#pragma unroll
    for (int j = 0; j < 4; ++j) mp[j] = (f32x4){bflo(w[j].x), bfhi(w[j].x), bflo(w[j].y), bfhi(w[j].y)};
    const float r = 1.0f / sqrtf(ssq4(mp, lane) * (1.0f / DM) + EPS);
#pragma unroll
    for (int j = 0; j < 4; ++j) xv[j] = xv[j] + mp[j] * r * ((const f32x4*)gpost)[lane + 64 * j];
}
DI void resnorm_row(f32x4 (&m)[4], const f32x4 (&xv)[4], const float* gpost, float* xout, const float* gpre, bf16* xn, const float* wr, int t, int* toke, int* tokp, float* tokw, gu32* cnt, int lane, unsigned char* age = nullptr, float* rowwe = nullptr, unsigned char* xn8 = nullptr) {
    const float r = 1.0f / sqrtf(ssq4(m, lane) * (1.0f / DM) + EPS);
#pragma unroll
    for (int j = 0; j < 4; ++j) { m[j] = xv[j] + m[j] * r * ((const f32x4*)gpost)[lane + 64 * j]; if (xout) ((f32x4*)xout)[lane + 64 * j] = m[j]; }
    if (gpre) {
        const float r2 = 1.0f / sqrtf(ssq4(m, lane) * (1.0f / DM) + EPS);
#pragma unroll
        for (int j = 0; j < 4; ++j) m[j] = m[j] * r2 * ((const f32x4*)gpre)[lane + 64 * j];
        if (xn8) {
#pragma unroll
            for (int j = 0; j < 4; ++j) ((unsigned*)xn8)[lane + 64 * j] = (unsigned)pk4_f8(m[j][0], m[j][1], m[j][2], m[j][3], (float)(1 << F8_XN)); }
        else if (!age) store_bf16_row(xn, lane, m);
        if (wr) {
            float lg[8];
#pragma unroll
            for (int e = 0; e < 8; ++e) lg[e] = 0.f;
#pragma unroll
            for (int j = 0; j < 4; ++j)
#pragma unroll
                for (int c = 0; c < 4; ++c) { const int k = 4 * (lane + 64 * j) + c; const f32x4 w0 = *(const f32x4*)(wr + k * 8), w1 = *(const f32x4*)(wr + k * 8 + 4); const float x = m[j][c];
                    lg[0] += x * w0[0]; lg[1] += x * w0[1]; lg[2] += x * w0[2]; lg[3] += x * w0[3]; lg[4] += x * w1[0]; lg[5] += x * w1[1]; lg[6] += x * w1[2]; lg[7] += x * w1[3]; }
#pragma unroll
            for (int e = 0; e < 8; ++e) lg[e] = wave_sum(lg[e], lane);
            int i0 = 0; float v0 = lg[0];
#pragma unroll
            for (int e = 1; e < 8; ++e) if (lg[e] > v0) { v0 = lg[e]; i0 = e; }
            int i1 = -1; float v1 = -3.0e38f;
#pragma unroll
            for (int e = 0; e < 8; ++e) if (e != i0 && lg[e] > v1) { v1 = lg[e]; i1 = e; }
            const float e1 = expf(v1 - v0); const float w0 = 1.0f / (1.0f + e1), w1 = e1 / (1.0f + e1);
            int p0 = 0, p1 = 0;
            if (lane == 0) { p0 = (int)__hip_atomic_fetch_add(cnt + 64 * i0, 1u, RLX_AGENT); p1 = (int)__hip_atomic_fetch_add(cnt + 64 * i1, 1u, RLX_AGENT);
                toke[2 * t] = i0; toke[2 * t + 1] = i1; tokp[2 * t] = p0; tokp[2 * t + 1] = p1; tokw[2 * t] = w0; tokw[2 * t + 1] = w1; }
            if (age) { p0 = __builtin_amdgcn_readfirstlane(p0); p1 = __builtin_amdgcn_readfirstlane(p1); const size_t r0 = (size_t)i0 * NT + p0, r1 = (size_t)i1 * NT + p1;
                if (lane == 0) { rowwe[r0] = w0; rowwe[r1] = w1; }
                unsigned* d0 = (unsigned*)(age + r0 * DM); unsigned* d1 = (unsigned*)(age + r1 * DM);
#pragma unroll
                for (int j = 0; j < 4; ++j) { const unsigned w = (unsigned)pk4_f8(m[j][0], m[j][1], m[j][2], m[j][3], (float)(1 << F8_XN)); d0[lane + 64 * j] = w; d1[lane + 64 * j] = w; } }
        }
    }
}

DI void mla_prep_row(const bf16* prow, const float* rope, const float* g_cq, const float* g_ckv, bf16* cq, bf16* kr, int lane) {
    { const uint2 w = *(const uint2*)(prow + O_BCQ + lane * 4); const float a = bflo(w.x), b = bfhi(w.x), c = bflo(w.y), d = bfhi(w.y);
      const float r = 1.0f / sqrtf(wave_sum(a * a + b * b + c * c + d * d, lane) * (1.0f / 256) + EPS); const f32x4 g = *(const f32x4*)(g_cq + lane * 4);
      *(uint2*)(cq + lane * 4) = make_uint2(pk2(a * r * g[0], b * r * g[1]), pk2(c * r * g[2], d * r * g[3])); }
    { const unsigned w = *(const unsigned*)(prow + O_BCKV + lane * 2); const float a = bflo(w), b = bfhi(w);
      const float r = 1.0f / sqrtf(wave_sum(a * a + b * b, lane) * (1.0f / 128) + EPS); *(unsigned*)(cq + 256 + lane * 2) = pk2(a * r * g_ckv[lane * 2], b * r * g_ckv[lane * 2 + 1]); }
    if (lane < 16) { const float c = rope[lane], s = rope[16 + lane]; const float x1 = bf1(prow[O_BKR + lane]), x2 = bf1(prow[O_BKR + 16 + lane]);
        kr[lane] = (bf16)f2bf(x1 * c - x2 * s); kr[16 + lane] = (bf16)f2bf(x2 * c + x1 * s); }
}
struct CompressOrder {
    int G, c;
    DI bool next(int i, pg8::Unit& u) const { const int L = i * G + c; if (L >= 64) return false; const int mt = L & 15, s = L >> 4, b = mt >> 2, which = (mt >> 1) & 1, g = mt & 1;
        u.pm = s * 16 + mt; u.pn = 0; u.aoff = ((long)b * SQ * NINP + (which ? O_CVC : O_CKC) + g * 64 + (long)s * 8 * NINP) * 2; u.boff = ((long)which * 256 * 2048 + s * 512) * 2; return true; }
    DI void a_ready(const pg8::Unit&) const {}
    DI void done(const pg8::Unit&) const {}
};
DI void compress_finish_item(const float* hidp, const float* cb, const float* w2, bf16* out, int b, int g, int which, int n, LAS float* hb, int lane) {
    const int mt = b * 4 + which * 2 + g; float a0 = cb[lane], a1 = cb[64 + lane];
#pragma unroll
    for (int s = 0; s < 4; ++s) { const float* p = hidp + ((size_t)(s * 16 + mt) * 256 + n) * 128; a0 += p[lane]; a1 += p[64 + lane]; }
    { const float u0 = 0.7978845608028654f * (a0 + 0.044715f * a0 * a0 * a0), u1 = 0.7978845608028654f * (a1 + 0.044715f * a1 * a1 * a1);
      hb[lane] = 0.5f * a0 * (1.0f + tanhf(u0)); hb[64 + lane] = 0.5f * a1 * (1.0f + tanhf(u1)); }
    LDS_WAIT(); asm volatile("" ::: "memory");
    float o = 0.f;
#pragma unroll 8
    for (int e = 0; e < 128; ++e) o += hb[e] * w2[e * 64 + lane];
    out[((size_t)(b * 2 + g) * 256 + n) * 64 + lane] = (bf16)f2bf(o);
    LDS_WAIT(); asm volatile("" ::: "memory");
}

DI void mix_row(const bf16* oa, const bf16* ob, const bf16* oc, const float* g_oa, const float* g_ob, const float* g_oc, bf16* mo, int lane) {
    { const uint2 w = *(const uint2*)(oa + lane * 4); const float a = bflo(w.x), b = bfhi(w.x), c = bflo(w.y), d = bfhi(w.y);
      const float r = 1.0f / sqrtf(wave_sum(a * a + b * b + c * c + d * d, lane) * (1.0f / 256) + EPS); const f32x4 g = *(const f32x4*)(g_oa + lane * 4);
      *(uint2*)(mo + lane * 4) = make_uint2(pk2(a * r * g[0], b * r * g[1]), pk2(c * r * g[2], d * r * g[3])); }
    { const uint2 w = *(const uint2*)(ob + lane * 4); const float a = bflo(w.x), b = bfhi(w.x), c = bflo(w.y), d = bfhi(w.y);
      const float r = 1.0f / sqrtf(wave_sum(a * a + b * b + c * c + d * d, lane) * (1.0f / 256) + EPS); const f32x4 g = *(const f32x4*)(g_ob + lane * 4);
      *(uint2*)(mo + 256 + lane * 4) = make_uint2(pk2(a * r * g[0], b * r * g[1]), pk2(c * r * g[2], d * r * g[3])); }
    { const v4u w = *(const v4u*)(oc + lane * 8); const float x[8] = {bflo(w.x), bfhi(w.x), bflo(w.y), bfhi(w.y), bflo(w.z), bfhi(w.z), bflo(w.w), bfhi(w.w)}; float s = 0.f;
#pragma unroll
      for (int i = 0; i < 8; ++i) s += x[i] * x[i];
      const float r = 1.0f / sqrtf(wave_sum(s, lane) * (1.0f / 512) + EPS); const f32x4 g0 = *(const f32x4*)(g_oc + lane * 8), g1 = *(const f32x4*)(g_oc + lane * 8 + 4);
      const v4u ov = {pk2(x[0] * r * g0[0], x[1] * r * g0[1]), pk2(x[2] * r * g0[2], x[3] * r * g0[3]), pk2(x[4] * r * g1[0], x[5] * r * g1[1]), pk2(x[6] * r * g1[2], x[7] * r * g1[3])};
      *(v4u*)(mo + 512 + lane * 8) = ov; }
}

struct TailColOrder {
    int G, c;
    DI bool next(int i, pg8::Unit& u) const { if (i > 0 || c < 64 || c >= 128) return false; u.pm = c - 64; u.pn = 8; u.aoff = 0; u.boff = 0; return true; }
    DI void a_ready(const pg8::Unit&) const {}
    DI void done(const pg8::Unit&) const {}
};
struct MoeOrder {
    int nN, G, c; const LAS int* tab; int cap; int ae = 0;
    DI bool next(int i, pg8::Unit& u) const { int nt = tab[16]; if (cap && nt > cap) nt = cap; int pm, n;
        if ((G & 7) == 0 && (nN == 4 || nN == 28)) { const int x = c & 7, Lx = i * (G >> 3) + (c >> 3);
            if (nN == 4) { const int cntp = (nt - x + 7) >> 3; if (Lx >= cntp * 4) return false; pm = x + 8 * (Lx >> 2); n = Lx & 3; }
            else { const int a = x & 1, bq = x >> 1, cntp = (nt - a + 1) >> 1; if (Lx >= cntp * 7) return false; const int pl = Lx / 7; pm = a + 2 * pl; n = 7 * bq + (Lx - 7 * pl); } }
        else { const int L = i * G + c; if (L >= nt * nN) return false; pm = L / nN; n = L - pm * nN; }
        const int e = tab[32 + pm]; u.pm = pm; u.pn = e * nN + n; u.aoff = 0; u.boff = 0;
        if (ae) { u.aoff = ((long)e * NT + (long)(pm * 256 - tab[e])) * 1024; u.boff = (long)u.pn * 256 * 1024; }
        return true; }
    DI void a_ready(const pg8::Unit&) const {}
    DI void done(const pg8::Unit&) const {}
};
struct MoeTailOrder {
    int G, c; const LAS int* tab;
    DI bool next(int i, pg8::Unit& u) const { const int L = i * G + c; const int P = tab[16] - 128; if (L >= P * 28) return false; const int pt = L / 28, r = L - pt * 28, n = r / 7, s = r - n * 7, pm = 128 + pt, e = tab[32 + pm];
        u.pm = pm | (s << 16); u.pn = n; u.aoff = (long)pm * 256 * DFE + s * 512; u.boff = ((long)e * 1024 + n * 256) * DFE + s * 512; return true; }
    DI void a_ready(const pg8::Unit&) const {}
    DI void done(const pg8::Unit&) const {}
};
DI f32x4 pair_vals(const bf16* PAIR, const bf16* PART, int r, int q) {
    if (r < 128 * 256) { const int w = ((const int*)((const unsigned char*)PAIR + (size_t)r * DM))[q];
        typedef float f2_ __attribute__((ext_vector_type(2))); const f2_ lo = __builtin_amdgcn_cvt_pk_f32_fp8(w, false), hi = __builtin_amdgcn_cvt_pk_f32_fp8(w, true); const float is = 1.0f / (float)(1 << F8_PAIR);
        return (f32x4){lo[0] * is, lo[1] * is, hi[0] * is, hi[1] * is}; }
    f32x4 a = {0.f, 0.f, 0.f, 0.f};
#pragma unroll
    for (int s = 0; s < 7; ++s) { const uint2 w = ((const uint2*)(PART + ((size_t)s * 8 * 256 + (r - 128 * 256)) * DM))[q]; a += (f32x4){bflo(w.x), bfhi(w.x), bflo(w.y), bfhi(w.y)}; }
    return a;
}
DI void moe_table(gu32* cnt, LAS int* tab, int tid) {
    if (tid == 0) { int o = 0, tix = 0;
        for (int e = 0; e < NEXP; ++e) { const int c = (int)__hip_atomic_load(cnt + 64 * e, RLX_AGENT); tab[e] = o; tab[20 + e] = c; const int nt = (c + 255) >> 8; for (int i = 0; i < nt; ++i) tab[32 + tix++] = e; o += nt * 256; }
        tab[8] = o; tab[16] = tix; }
    __syncthreads();
}

namespace fa {
typedef float f32x16 __attribute__((ext_vector_type(16)));
typedef unsigned u32x2 __attribute__((ext_vector_type(2)));
constexpr int VP = 136, MERGE_OFF = 88064, BLIST_OFF = 122880;
constexpr float NEG = -1e30f;
#define FA_BAR() asm volatile("s_waitcnt lgkmcnt(0)\n\ts_barrier" ::: "memory")
struct Src { const bf16* k1; int k1p; const bf16* k2; const bf16* v; int vp; };
DI int crow(int i, int h) { return (i & 3) + 8 * (i >> 2) + 4 * h; }
DI f32x16 mfma32(bf16x8 a, bf16x8 b, f32x16 c) { return __builtin_amdgcn_mfma_f32_32x32x16_bf16(a, b, c, 0, 0, 0); }
typedef float f32x2v __attribute__((ext_vector_type(2))); typedef __bf16 bf16x2v __attribute__((ext_vector_type(2)));
DI unsigned cvtpk(float lo, float hi) { const f32x2v v = {lo, hi}; return __builtin_bit_cast(unsigned, __builtin_convertvector(v, bf16x2v)); }
DI unsigned pkw(unsigned lo16, unsigned hi16, bool hi) { return hi ? ((lo16 >> 16) | (hi16 & 0xffff0000u)) : ((lo16 & 0xffffu) | (hi16 << 16)); }

template <int DQK, bool SEL, bool BIAS>
DI void unit(LAS unsigned char* L, const Src src, const bf16* qrow, const float* roperow, int tq, float slope2, float m_init, float l_init, unsigned long long selmask, int W, float qscale, int tid, float (&o)[32], const bf16x8* qpre = nullptr, int seq_first = -1, int seq_n = 0) {
    constexpr int KP = DQK == 64 ? 144 : 208, CH = DQK / 8, KHALF = 64 * KP, VHALF = 64 * VP, STAGE = 2 * (KHALF + VHALF), NKL = CH * 64 / 256;
    const int lane = tid & 63, wave = __builtin_amdgcn_readfirstlane(tid >> 6), rs = wave & 3, kh = wave >> 2, r32 = lane & 31, h = lane >> 5, gt = tid & 255;
    const LAS int* blist = (const LAS int*)(L + BLIST_OFF);
    v4u kreg[NKL], vreg[2];
    const int vkp = gt >> 3, vdc = gt & 7;
#define FA_ISSUE_AT(valid_, key0e_) do { if (valid_) { const int key0_ = (key0e_); \
        _Pragma("unroll") for (int i_ = 0; i_ < NKL; ++i_) { const int c_ = gt + 256 * i_, key_ = c_ / CH, ch_ = c_ - key_ * CH; \
            const bf16* sp_ = (DQK == 64 || ch_ < 8) ? src.k1 + (size_t)(key0_ + key_) * src.k1p + 8 * ch_ : src.k2 + (size_t)(key0_ + key_) * 32 + 8 * (ch_ - 8); kreg[i_] = *(const v4u*)sp_; } \
        vreg[0] = *(const v4u*)(src.v + (size_t)(key0_ + 2 * vkp) * src.vp + 8 * vdc); vreg[1] = *(const v4u*)(src.v + (size_t)(key0_ + 2 * vkp + 1) * src.vp + 8 * vdc); } } while (0)
    if (seq_first >= 0) FA_ISSUE_AT(kh < seq_n, 64 * (seq_first + kh));
    bf16x8 qf[DQK / 16];
    if (qpre) {
#pragma unroll
        for (int d0 = 0; d0 < DQK / 16; ++d0) qf[d0] = qpre[d0];
    } else {
        float qv[DQK / 16][8];
#pragma unroll
        for (int d0 = 0; d0 < DQK / 16; ++d0) { const v4u w = *(const v4u*)(qrow + 16 * d0 + 8 * h);
            qv[d0][0] = bflo(w.x); qv[d0][1] = bfhi(w.x); qv[d0][2] = bflo(w.y); qv[d0][3] = bfhi(w.y); qv[d0][4] = bflo(w.z); qv[d0][5] = bfhi(w.z); qv[d0][6] = bflo(w.w); qv[d0][7] = bfhi(w.w); }
        if (DQK > 64) {
#pragma unroll
            for (int j = 0; j < 8; ++j) { const float c = roperow[8 * h + j], s = roperow[16 + 8 * h + j]; const float x1 = qv[4][j], x2 = qv[5][j]; qv[4][j] = x1 * c - x2 * s; qv[5][j] = x2 * c + x1 * s; }
        }
#pragma unroll
        for (int d0 = 0; d0 < DQK / 16; ++d0) { const v4u w = {cvtpk(qv[d0][0] * qscale, qv[d0][1] * qscale), cvtpk(qv[d0][2] * qscale, qv[d0][3] * qscale), cvtpk(qv[d0][4] * qscale, qv[d0][5] * qscale), cvtpk(qv[d0][6] * qscale, qv[d0][7] * qscale)};
            qf[d0] = __builtin_bit_cast(bf16x8, w); }
    }
    f32x16 O0, O1;
#pragma unroll
    for (int i = 0; i < 16; ++i) { O0[i] = 0.f; O1[i] = 0.f; }
    float m = m_init, l = l_init;
    FA_BAR();
    const int nblk = blist[0], nsteps = (nblk + 1) >> 1;
#define FA_ISSUE(step_) do { const int bi_ = 2 * (step_) + kh; FA_ISSUE_AT(bi_ < nblk, 64 * blist[1 + bi_]); } while (0)
#define FA_STORE(step_, stage_) do { const int bi_ = 2 * (step_) + kh; if (bi_ < nblk) { LAS unsigned char* kb_ = L + (stage_) * STAGE + kh * KHALF; LAS unsigned char* vb_ = L + (stage_) * STAGE + 2 * KHALF + kh * VHALF; \
        _Pragma("unroll") for (int i_ = 0; i_ < NKL; ++i_) { const int c_ = gt + 256 * i_, key_ = c_ / CH, ch_ = c_ - key_ * CH; *(LAS v4u*)(kb_ + key_ * KP + ch_ * 16) = kreg[i_]; } \
        LAS unsigned char* vw_ = vb_ + (8 * vdc) * VP + 4 * vkp; \
        *(LAS unsigned*)(vw_ + 0 * VP) = pkw(vreg[0].x, vreg[1].x, false); *(LAS unsigned*)(vw_ + 1 * VP) = pkw(vreg[0].x, vreg[1].x, true); \
        *(LAS unsigned*)(vw_ + 2 * VP) = pkw(vreg[0].y, vreg[1].y, false); *(LAS unsigned*)(vw_ + 3 * VP) = pkw(vreg[0].y, vreg[1].y, true); \
        *(LAS unsigned*)(vw_ + 4 * VP) = pkw(vreg[0].z, vreg[1].z, false); *(LAS unsigned*)(vw_ + 5 * VP) = pkw(vreg[0].z, vreg[1].z, true); \
        *(LAS unsigned*)(vw_ + 6 * VP) = pkw(vreg[0].w, vreg[1].w, false); *(LAS unsigned*)(vw_ + 7 * VP) = pkw(vreg[0].w, vreg[1].w, true); } } while (0)
    if (nsteps > 0) { if (seq_first < 0) FA_ISSUE(0); FA_STORE(0, 0); }
    for (int step = 0; step < nsteps; ++step) {
        const int stage = step & 1;
        if (step + 1 < nsteps) FA_ISSUE(step + 1);
        FA_BAR();
        const int bi = 2 * step + kh;
        if (bi < nblk) {
            const int kb = blist[1 + bi];
            const LAS unsigned char* Kb = L + stage * STAGE + kh * KHALF; const LAS unsigned char* Vb = L + stage * STAGE + 2 * KHALF + kh * VHALF;
            f32x16 X0, X1;
#pragma unroll
            for (int i = 0; i < 16; ++i) { X0[i] = 0.f; X1[i] = 0.f; }
#pragma unroll
            for (int d0 = 0; d0 < DQK / 16; ++d0) { const bf16x8 a0 = *(const LAS bf16x8*)(Kb + r32 * KP + (16 * d0 + 8 * h) * 2), a1 = *(const LAS bf16x8*)(Kb + (32 + r32) * KP + (16 * d0 + 8 * h) * 2);
                X0 = mfma32(a0, qf[d0], X0); X1 = mfma32(a1, qf[d0], X1); }
            const int db = tq - 64 * kb - 4 * h; bool rowok = true; if (SEL) rowok = (selmask >> kb) & 1ull;
            const int tqlo = __builtin_amdgcn_readfirstlane(tq);
            const bool interior = (64 * kb + 63 <= tqlo) && (tqlo + 31 - 64 * kb < W);
            const float base = BIAS ? -slope2 * (float)db : 0.f;
            float mx = NEG;
            if (interior) {
#pragma unroll
                for (int i = 0; i < 16; ++i) { const float cf = (float)((i & 3) + 8 * (i >> 2));
                    if (BIAS) { X0[i] = fmaf(slope2, cf, X0[i]); X1[i] = fmaf(slope2, cf + 32.f, X1[i]); }
                    mx = fmaxf(mx, fmaxf(X0[i], X1[i])); }
            } else {
#pragma unroll
                for (int i = 0; i < 16; ++i) { const int c0 = (i & 3) + 8 * (i >> 2);
                    { const int d = db - c0; const float x = BIAS ? fmaf(slope2, (float)c0, X0[i]) : X0[i]; const bool ok = (unsigned)d < (unsigned)W; X0[i] = ok ? x : NEG; }
                    { const int d = db - c0 - 32; const float x = BIAS ? fmaf(slope2, (float)(c0 + 32), X1[i]) : X1[i]; const bool ok = (unsigned)d < (unsigned)W; X1[i] = ok ? x : NEG; }
                    mx = fmaxf(mx, fmaxf(X0[i], X1[i])); }
            }
            mx = mx + base; if (SEL) mx = rowok ? mx : NEG;
            if (__builtin_amdgcn_ballot_w64(mx > m + 8.0f)) { mx = fmaxf(mx, shx(mx, 32, lane)); const float mnew = fmaxf(m, mx); const float alpha = __builtin_amdgcn_exp2f(m - mnew); l *= alpha; m = mnew;
#pragma unroll
                for (int i = 0; i < 16; ++i) { O0[i] *= alpha; O1[i] *= alpha; } }
            float mref = m - base; if (SEL) mref = rowok ? mref : 1e30f;
            float ls = 0.f;
#pragma unroll
            for (int i = 0; i < 16; ++i) { X0[i] = __builtin_amdgcn_exp2f(X0[i] - mref); X1[i] = __builtin_amdgcn_exp2f(X1[i] - mref); ls += X0[i] + X1[i]; }
            l += ls;
#pragma unroll
            for (int kt = 0; kt < 2; ++kt)
#pragma unroll
                for (int s = 0; s < 2; ++s) {
                    const f32x16& X = kt ? X1 : X0;
                    const v4u pw = {cvtpk(X[8 * s + 0], X[8 * s + 1]), cvtpk(X[8 * s + 2], X[8 * s + 3]), cvtpk(X[8 * s + 4], X[8 * s + 5]), cvtpk(X[8 * s + 6], X[8 * s + 7])};
                    const bf16x8 pf = __builtin_bit_cast(bf16x8, pw);
                    const int kofs = (32 * kt + 16 * s + 4 * h) * 2;
                    { const u32x2 lo = *(const LAS u32x2*)(Vb + r32 * VP + kofs), hi = *(const LAS u32x2*)(Vb + r32 * VP + kofs + 16); const v4u vw = {lo.x, lo.y, hi.x, hi.y};
                      O0 = mfma32(__builtin_bit_cast(bf16x8, vw), pf, O0); }
                    { const u32x2 lo = *(const LAS u32x2*)(Vb + (32 + r32) * VP + kofs), hi = *(const LAS u32x2*)(Vb + (32 + r32) * VP + kofs + 16); const v4u vw = {lo.x, lo.y, hi.x, hi.y};
                      O1 = mfma32(__builtin_bit_cast(bf16x8, vw), pf, O1); }
                }
        }
        if (step + 1 < nsteps) FA_STORE(step + 1, stage ^ 1);
    }
#undef FA_ISSUE
#undef FA_ISSUE_AT
#undef FA_STORE
    l += shx(l, 32, lane);
    LAS float* mg = (LAS float*)(L + MERGE_OFF) + rs * 64 + lane;
    if (kh == 1) { mg[0] = m; mg[256] = l;
#pragma unroll
        for (int i = 0; i < 16; ++i) { mg[(2 + i) * 256] = O0[i]; mg[(18 + i) * 256] = O1[i]; } }
    FA_BAR();
    if (kh == 0) { const float m2 = mg[0], l2 = mg[256]; const float mf = fmaxf(m, m2), a1 = __builtin_amdgcn_exp2f(m - mf), a2 = __builtin_amdgcn_exp2f(m2 - mf);
        const float inv = 1.0f / (l * a1 + l2 * a2);
#pragma unroll
        for (int i = 0; i < 16; ++i) { o[i] = (O0[i] * a1 + mg[(2 + i) * 256] * a2) * inv; o[16 + i] = (O1[i] * a1 + mg[(18 + i) * 256] * a2) * inv; } }
}
DI void make_qf64(const bf16* qrow, int h, float qscale, bf16x8 (&qf)[4]) {
#pragma unroll
    for (int d0 = 0; d0 < 4; ++d0) { const v4u w = *(const v4u*)(qrow + 16 * d0 + 8 * h);
        const v4u ws = {cvtpk(bflo(w.x) * qscale, bfhi(w.x) * qscale), cvtpk(bflo(w.y) * qscale, bfhi(w.y) * qscale), cvtpk(bflo(w.z) * qscale, bfhi(w.z) * qscale), cvtpk(bflo(w.w) * qscale, bfhi(w.w) * qscale)};
        qf[d0] = __builtin_bit_cast(bf16x8, ws); }
}
DI void store_row(bf16* orow, const float (&o)[32], int h) {
    typedef unsigned u2v __attribute__((ext_vector_type(2)));
#pragma unroll
    for (int dblk = 0; dblk < 2; ++dblk)
#pragma unroll
        for (int q = 0; q < 2; ++q) { const int ia = 16 * dblk + 8 * q, ib = ia + 4;
            const unsigned a0 = cvtpk(o[ia], o[ia + 1]), a1 = cvtpk(o[ia + 2], o[ia + 3]), b0 = cvtpk(o[ib], o[ib + 1]), b1 = cvtpk(o[ib + 2], o[ib + 3]);
            const u2v s0 = __builtin_amdgcn_permlane32_swap(a0, b0, false, false), s1 = __builtin_amdgcn_permlane32_swap(a1, b1, false, false);
            const v4u w = {s0[0], s1[0], s0[1], s1[1]};
            *(v4u*)(orow + 32 * dblk + 16 * q + 8 * h) = w; }
}
}
constexpr float LOG2E = 1.4426950408889634f;
DI void store_head(bf16* ocat_row, float* ssq, const float (&o)[32], int h, int lane) {
    fa::store_row(ocat_row, o, h);
    float s = 0.f;
#pragma unroll
    for (int i = 0; i < 32; ++i) s += o[i] * o[i];
    s += shx(s, 32, lane);
    if (h == 0) *ssq = s;
}
DI void fa_write_blist(LAS unsigned char* L, int first, int last, int tid) {
    if (tid < 64) { LAS int* bl = (LAS int*)(L + fa::BLIST_OFF); const int n = last - first + 1; if (tid < n) bl[1 + tid] = first + tid; if (tid == 0) bl[0] = n; }
}
DI void attn_a_unit(LAS unsigned char* L, const bf16* PROJ, const float* sinks, bf16* OCAT, float* SSQ, int b, int g, int c, int tid) {
    const int lane = tid & 63, wave = __builtin_amdgcn_readfirstlane(tid >> 6), rs = wave & 3, kh = wave >> 2, r32 = lane & 31, h = lane >> 5;
    const int r = rs >> 1, t = 64 * c + 32 * (rs & 1) + r32, hq = 2 * g + r;
    fa_write_blist(L, c - 2 > 0 ? c - 2 : 0, c, tid);
    const fa::Src s{PROJ + (size_t)b * SQ * NINP + O_AK + g * 64, NINP, nullptr, PROJ + (size_t)b * SQ * NINP + O_AV + g * 64, NINP};
    float o[32];
    fa::unit<64, false, true>(L, s, PROJ + (size_t)(b * SQ + t) * NINP + O_AQ + hq * 64, nullptr, t, exp2f(-2.0f * (float)(hq + 1)) * LOG2E, sinks[hq] * LOG2E, (kh == 0 && h == 0) ? 1.f : 0.f, 0ull, 128, 0.125f * LOG2E, tid, o, nullptr, c - 2 > 0 ? c - 2 : 0, c - (c - 2 > 0 ? c - 2 : 0) + 1);
    if (kh == 0) store_head(OCAT + (size_t)(b * SQ + t) * 1024 + hq * 64, SSQ + (size_t)(b * SQ + t) * 16 + hq, o, h, lane);
}
DI void attn_b_unit(LAS unsigned char* L, const bf16* QB, const bf16* KVB, const bf16* KR, const float* ROPE, bf16* OCAT, float* SSQ, int b, int hd, int c, int tid) {
    const int lane = tid & 63, wave = __builtin_amdgcn_readfirstlane(tid >> 6), rs = wave & 3, kh = wave >> 2, r32 = lane & 31, h = lane >> 5;
    const int t = 128 * c + 32 * rs + r32;
    fa_write_blist(L, 0, 2 * c + 1, tid);
    const fa::Src s{KVB + (size_t)b * SQ * 512 + hd * 128, 512, KR + (size_t)b * SQ * 32, KVB + (size_t)b * SQ * 512 + hd * 128 + 64, 512};
    float o[32];
    fa::unit<96, false, false>(L, s, QB + (size_t)(b * SQ + t) * 384 + hd * 96, ROPE + (size_t)(b * SQ + t) * 32, t, 0.f, fa::NEG, 0.f, 0ull, 1 << 30, 0.10206207261596575f * LOG2E, tid, o, nullptr, 0, 2 * c + 2);
    if (kh == 0) store_head(OCAT + (size_t)(b * SQ + t) * 1024 + 256 + hd * 64, SSQ + (size_t)(b * SQ + t) * 16 + 4 + hd, o, h, lane);
}
DI int wg_pop(gu32* ctr, LAS int* slot, int tid) {
    __syncthreads();
    if (tid == 0) *slot = (int)__hip_atomic_fetch_add(ctr, 1u, RLX_AGENT);
    __syncthreads();
    return *slot;
}
namespace cmpu {
constexpr int CK = 0, CV = 36864, XMX = 70144, XLS = 71168, XO = 72192, SLAB = 0, IMPF = 104960, KP = 144, VPC = 520, MASK_OFF = RING_BYTES + 640;
DI void unit(LAS unsigned char* L, const bf16* kcb, const bf16* vcb, const bf16* qrow, float qscale, bf16x8 (&qf)[4], int tq, float slope2, int c, int tid, float (&o)[32]) {
    using fa::f32x16; using fa::u32x2; using fa::mfma32; using fa::NEG;
    const int lane = tid & 63, wave = __builtin_amdgcn_readfirstlane(tid >> 6), rs = wave & 3, kh = wave >> 2, r32 = lane & 31, h = lane >> 5;
    const int nv = 2 * c + 1, ntile = (nv + 31) >> 5;
    const int nkc = 32 * ntile * 8, nvt = 16 * ntile * 8;
    v4u kcr[4], v0r[2], v1r[2];
#pragma unroll
    for (int i = 0; i < 4; ++i) { const int ci = tid + 512 * i; if (ci < nkc) kcr[i] = *(const v4u*)(kcb + (ci >> 3) * 64 + (ci & 7) * 8); }
#pragma unroll
    for (int i = 0; i < 2; ++i) { const int tk = tid + 512 * i; if (tk < nvt) { const int kp = tk >> 3, dc = tk & 7; v0r[i] = *(const v4u*)(vcb + (2 * kp) * 64 + 8 * dc); v1r[i] = *(const v4u*)(vcb + (2 * kp + 1) * 64 + 8 * dc); } }
    fa::make_qf64(qrow, h, qscale, qf);
    FA_BAR();
#pragma unroll
    for (int i = 0; i < 4; ++i) { const int ci = tid + 512 * i; if (ci < nkc) *(LAS v4u*)(L + CK + (ci >> 3) * KP + (ci & 7) * 16) = kcr[i]; }
#pragma unroll
    for (int i = 0; i < 2; ++i) { const int tk = tid + 512 * i; if (tk < nvt) { const int kp = tk >> 3, dc = tk & 7; const v4u v0 = v0r[i], v1 = v1r[i];
        LAS unsigned char* vw = L + CV + (8 * dc) * VPC + 4 * kp;
        *(LAS unsigned*)(vw + 0 * VPC) = fa::pkw(v0.x, v1.x, false); *(LAS unsigned*)(vw + 1 * VPC) = fa::pkw(v0.x, v1.x, true); *(LAS unsigned*)(vw + 2 * VPC) = fa::pkw(v0.y, v1.y, false); *(LAS unsigned*)(vw + 3 * VPC) = fa::pkw(v0.y, v1.y, true);
        *(LAS unsigned*)(vw + 4 * VPC) = fa::pkw(v0.z, v1.z, false); *(LAS unsigned*)(vw + 5 * VPC) = fa::pkw(v0.z, v1.z, true); *(LAS unsigned*)(vw + 6 * VPC) = fa::pkw(v0.w, v1.w, false); *(LAS unsigned*)(vw + 7 * VPC) = fa::pkw(v0.w, v1.w, true); } }
    FA_BAR();
    f32x16 X[4]; float mx = NEG;
#pragma unroll
    for (int jt = 0; jt < 4; ++jt) { const int tau = 2 * jt + kh;
#pragma unroll
        for (int i = 0; i < 16; ++i) X[jt][i] = 0.f;
        if (tau < ntile) {
#pragma unroll
            for (int d0 = 0; d0 < 4; ++d0) { const bf16x8 a = *(const LAS bf16x8*)(L + CK + (32 * tau + r32) * KP + (16 * d0 + 8 * h) * 2); X[jt] = mfma32(a, qf[d0], X[jt]); }
            const int db = tq - 31 - 16 * (32 * tau + 4 * h);
#pragma unroll
            for (int i = 0; i < 16; ++i) { const int d = db - 16 * ((i & 3) + 8 * (i >> 2)); const float x = fmaf(-slope2, (float)d, X[jt][i]); X[jt][i] = d >= 0 ? x : NEG; mx = fmaxf(mx, X[jt][i]); }
        } else {
#pragma unroll
            for (int i = 0; i < 16; ++i) X[jt][i] = NEG;
        } }
    mx = fmaxf(mx, shx(mx, 32, lane));
    LAS float* xm = (LAS float*)(L + XMX); LAS float* xl = (LAS float*)(L + XLS);
    if (h == 0) xm[kh * 128 + rs * 32 + r32] = mx;
    FA_BAR();
    const float m = fmaxf(xm[rs * 32 + r32], xm[128 + rs * 32 + r32]);
    float ls = 0.f;
#pragma unroll
    for (int jt = 0; jt < 4; ++jt)
#pragma unroll
        for (int i = 0; i < 16; ++i) { const float x = X[jt][i]; const float p = x > -1e29f ? __builtin_amdgcn_exp2f(x - m) : 0.f; X[jt][i] = p; ls += p; }
    ls += shx(ls, 32, lane);
    if (h == 0) xl[kh * 128 + rs * 32 + r32] = ls;
    FA_BAR();
    const float lt = xl[rs * 32 + r32] + xl[128 + rs * 32 + r32]; const float inv = lt > 0.f ? 1.0f / lt : 0.f;
    const bool need_imp = c >= 32;
    f32x16 O0, O1, I0, I1;
#pragma unroll
    for (int i = 0; i < 16; ++i) { O0[i] = 0.f; O1[i] = 0.f; I0[i] = 0.f; I1[i] = 0.f; }
#pragma unroll
    for (int jt = 0; jt < 4; ++jt) { const int tau = 2 * jt + kh;
        if (tau < ntile) {
#pragma unroll
            for (int s = 0; s < 2; ++s) {
                const v4u pw = {fa::cvtpk(X[jt][8 * s + 0] * inv, X[jt][8 * s + 1] * inv), fa::cvtpk(X[jt][8 * s + 2] * inv, X[jt][8 * s + 3] * inv), fa::cvtpk(X[jt][8 * s + 4] * inv, X[jt][8 * s + 5] * inv), fa::cvtpk(X[jt][8 * s + 6] * inv, X[jt][8 * s + 7] * inv)};
                const bf16x8 pf = __builtin_bit_cast(bf16x8, pw);
                const int kofs = (32 * tau + 16 * s + 4 * h) * 2;
                { const u32x2 lo = *(const LAS u32x2*)(L + CV + r32 * VPC + kofs), hi = *(const LAS u32x2*)(L + CV + r32 * VPC + kofs + 16); const v4u vw = {lo.x, lo.y, hi.x, hi.y}; O0 = mfma32(__builtin_bit_cast(bf16x8, vw), pf, O0); }
                { const u32x2 lo = *(const LAS u32x2*)(L + CV + (32 + r32) * VPC + kofs), hi = *(const LAS u32x2*)(L + CV + (32 + r32) * VPC + kofs + 16); const v4u vw = {lo.x, lo.y, hi.x, hi.y}; O1 = mfma32(__builtin_bit_cast(bf16x8, vw), pf, O1); }
#pragma unroll
                for (int jb = 0; jb < 2; ++jb) { if (!need_imp || (jb != (tau >> 2) && !(tau == 3 && jb == 1))) continue;
                    const int nb = 32 * tau + 16 * s + 4 * h - 4 * (32 * jb + r32); unsigned ww[4];
#pragma unroll
                    for (int q2 = 0; q2 < 4; ++q2) { const int d0 = nb + 8 * (q2 >> 1) + 2 * (q2 & 1), d1 = d0 + 1;
                        const unsigned w0 = (d0 == -1 || d0 == 3) ? 0x3f80u : ((unsigned)d0 <= 2u ? 0x4000u : 0u), w1 = (d1 == -1 || d1 == 3) ? 0x3f80u : ((unsigned)d1 <= 2u ? 0x4000u : 0u); ww[q2] = w0 | (w1 << 16); }
                    const v4u aw = {ww[0], ww[1], ww[2], ww[3]};
                    if (jb == 0) I0 = mfma32(__builtin_bit_cast(bf16x8, aw), pf, I0); else I1 = mfma32(__builtin_bit_cast(bf16x8, aw), pf, I1); }
            } } }
    FA_BAR();
    if (need_imp) { LAS float* sl = (LAS float*)(L + SLAB) + wave * 2048 + r32;
#pragma unroll
      for (int i = 0; i < 16; ++i) { const int j = fa::crow(i, h); sl[j * 32] = I0[i]; sl[(32 + j) * 32] = I1[i]; } }
    LAS float* xo = (LAS float*)(L + XO) + rs * 64 + lane;
    if (kh == 1) {
#pragma unroll
        for (int i = 0; i < 16; ++i) { xo[i * 256] = O0[i]; xo[(16 + i) * 256] = O1[i]; } }
    FA_BAR();
    if (kh == 0) {
#pragma unroll
        for (int i = 0; i < 16; ++i) { o[i] = O0[i] + xo[i * 256]; o[16 + i] = O1[i] + xo[(16 + i) * 256]; } }
    if (need_imp) { const LAS float* sl = (const LAS float*)(L + SLAB); LAS float* imp = (LAS float*)(L + IMPF);
#pragma unroll
      for (int k = 0; k < 4; ++k) { const int e = tid + 512 * k, j = e >> 5, tl = e & 31; float a = 0.f;
#pragma unroll
          for (int w = 0; w < 8; ++w) a += sl[w * 2048 + j * 32 + tl];
          imp[tl * 64 + j] = a; } }
    FA_BAR();
    if (!need_imp) { LAS unsigned long long* mk = (LAS unsigned long long*)(L + MASK_OFF);
      if (tid < 32) { const int t = 32 * c + tid; mk[tid] = (2ull << (t >> 6)) - 1ull; } }
    else { const LAS float* imp = (const LAS float*)(L + IMPF); LAS unsigned long long* mk = (LAS unsigned long long*)(L + MASK_OFF);
#pragma unroll 1
      for (int k = 0; k < 4; ++k) { const int tl = wave + 8 * k, t = 32 * c + tl, j = lane, cur = t >> 6;
          const bool avail = 64 * j <= t, forced = (j == 0) || (j == cur) || (j == cur - 1);
          float val = avail ? imp[tl * 64 + j] : -1e30f; if (forced) val = 1e30f;
          const unsigned fb = __float_as_uint(val), key = (fb & 0x80000000u) ? ~fb : (fb | 0x80000000u);
          unsigned res = 0u;
#pragma unroll
          for (int bit = 31; bit >= 0; --bit) { const unsigned cand = res | (1u << bit); const int cnt = __builtin_popcountll(__builtin_amdgcn_ballot_w64(key >= cand)); if (cnt >= 16) res = cand; }
          const unsigned long long gt = __builtin_amdgcn_ballot_w64(key > res), eq = __builtin_amdgcn_ballot_w64(key == res);
          const int need = 16 - __builtin_popcountll(gt);
          const int before = __builtin_popcountll(eq & ((1ull << j) - 1ull));
          const bool sel = (key > res) || (key == res && before < need);
          const unsigned long long bal = __builtin_amdgcn_ballot_w64(sel && avail);
          if (lane == 0) mk[tl] = bal; } }
    FA_BAR();
}
}

DI void attn_c_unit(LAS unsigned char* L, const bf16* PROJ, const bf16* KCb, const bf16* VCb, bf16* OCAT, float* SSQ, int b, int g, int c, int tid) {
    const int lane = tid & 63, wave = __builtin_amdgcn_readfirstlane(tid >> 6), rs = wave & 3, kh = wave >> 2, r32 = lane & 31, h = lane >> 5;
    const int t = 32 * c + r32, hq = 4 * g + rs; const float slope2 = exp2f(-(float)(hq + 1)) * LOG2E;
    const bf16* prow = PROJ + (size_t)(b * SQ + t) * NINP; const bf16* qrow = prow + O_CQ + hq * 64; const bf16* kvb = PROJ + (size_t)b * SQ * NINP + g * 64;
    float o[32], acc[32];
    bf16x8 qf[4];
    cmpu::unit(L, KCb + (size_t)(b * 2 + g) * 256 * 64, VCb + (size_t)(b * 2 + g) * 256 * 64, qrow, 0.125f * LOG2E, qf, t, slope2, c, tid, o);
    { const float g0 = 1.0f / (1.0f + __expf(-bf1(prow[O_CG + hq * 3 + 0])));
#pragma unroll
      for (int i = 0; i < 32; ++i) acc[i] = g0 * o[i]; }
    { const int lo = 32 * c - 511; fa_write_blist(L, (lo > 0 ? lo : 0) >> 6, (32 * c + 31) >> 6, tid);
      const fa::Src s{kvb + O_CKW, NINP, nullptr, kvb + O_CVW, NINP};
      fa::unit<64, false, true>(L, s, qrow, nullptr, t, slope2, fa::NEG, 0.f, 0ull, 512, 0.125f * LOG2E, tid, o, qf, (lo > 0 ? lo : 0) >> 6, ((32 * c + 31) >> 6) - ((lo > 0 ? lo : 0) >> 6) + 1);
      const float g2 = 1.0f / (1.0f + __expf(-bf1(prow[O_CG + hq * 3 + 2])));
#pragma unroll
      for (int i = 0; i < 32; ++i) acc[i] += g2 * o[i]; }
    { const unsigned long long mk = ((const LAS unsigned long long*)(L + cmpu::MASK_OFF))[r32];
      if (wave == 0) { unsigned lo = (unsigned)mk, hi = (unsigned)(mk >> 32);
#pragma unroll
          for (int x = 16; x > 0; x >>= 1) { lo |= shxu(lo, x, lane); hi |= shxu(hi, x, lane); }
          { LAS int* bl = (LAS int*)(L + fa::BLIST_OFF); const unsigned long long um = ((unsigned long long)hi << 32) | lo;
            if ((um >> lane) & 1ull) bl[1 + __builtin_popcountll(um & ((1ull << lane) - 1ull))] = lane; if (lane == 0) bl[0] = __builtin_popcountll(um); } }
      const fa::Src s{kvb + O_CKS, NINP, nullptr, kvb + O_CVS, NINP};
      fa::unit<64, true, true>(L, s, qrow, nullptr, t, slope2, fa::NEG, 0.f, mk, 1 << 30, 0.125f * LOG2E, tid, o, qf);
      const float g1 = 1.0f / (1.0f + __expf(-bf1(prow[O_CG + hq * 3 + 1])));
#pragma unroll
      for (int i = 0; i < 32; ++i) acc[i] += g1 * o[i]; }
    if (kh == 0) store_head(OCAT + (size_t)(b * SQ + t) * 1024 + 512 + hq * 64, SSQ + (size_t)(b * SQ + t) * 16 + 8 + hq, acc, h, lane);
}

#define BUFS() GAS unsigned char* wsl = (GAS unsigned char*)ws; asm volatile("" : "+s"(wsl)); int tidp_; asm volatile("v_mbcnt_lo_u32_b32 %0, -1, 0\n\tv_mbcnt_hi_u32_b32 %0, -1, %0" : "=v"(tidp_)); tidp_ += wave_s * 64; const int tid = tidp_, lane = tid & 63, wave = __builtin_amdgcn_readfirstlane(tid >> 6), gw = blockIdx.x * NWAVES + wave; (void)tid; (void)lane; (void)gw; \
    bf16 *WIN = (bf16*)(wsl + WS_WIN), *WUP = (bf16*)(wsl + WS_WUP), *WO = (bf16*)(wsl + WS_WO), *WGU = (bf16*)(wsl + WS_WGU), *WD = (bf16*)(wsl + WS_WD); \
    float* ROPE = (float*)(wsl + WS_ROPE); \
    int *TOKE = (int*)(wsl + WS_TOKE), *TOKP = (int*)(wsl + WS_TOKP), *ROWTOK = (int*)(wsl + WS_ROWTOK); float *TOKW = (float*)(wsl + WS_TOKW), *ROWW = (float*)(wsl + WS_ROWW), *ROWWE = (float*)(wsl + WS_ROWWE); (void)ROWW; (void)ROWWE; (void)ROWTOK; float* SSQ0 = (float*)(wsl + WS_SSQ); (void)SSQ0; \
    bf16 *PROJ = (bf16*)(wsl + WS_PROJ), *CQKV = (bf16*)(wsl + WS_CQKV), *QB = (bf16*)(wsl + WS_QB), *KVB = (bf16*)(wsl + WS_KVB), *KR = (bf16*)(wsl + WS_KR), *OA = (bf16*)(wsl + WS_OA), *OB = (bf16*)(wsl + WS_OB), \
         *OCMP = (bf16*)(wsl + WS_OCMP), *OSLC = (bf16*)(wsl + WS_OSLC), *OWIN = (bf16*)(wsl + WS_OWIN), *XN = (bf16*)(wsl + WS_XN), *MIXED = (bf16*)(wsl + WS_MIXED), *HIDB = (bf16*)(wsl + WS_HIDB), \
         *MGU = (bf16*)(wsl + WS_MGU), *AG = (bf16*)(wsl + WS_AG), *HIDM = (bf16*)(wsl + WS_HIDM), *MD = (bf16*)(wsl + WS_MD), *PAIR = (bf16*)(wsl + WS_PAIR), *PART = (bf16*)(wsl + WS_PART); \
    bf16 *WC1 = (bf16*)(wsl + WS_WC1); float *HIDP = (float*)(wsl + WS_HIDP), *CBIAS = (float*)(wsl + WS_CBIAS), *CBPART = (float*)(wsl + WS_CBIAS + 65536); bf16 *KCB = (bf16*)(wsl + WS_KC), *VCB = (bf16*)(wsl + WS_VC), *OC = (bf16*)(wsl + WS_OCMP); bf16 *MOUT = (bf16*)(wsl + WS_MOUT), *FOUT = (bf16*)(wsl + WS_FOUT); \
    unsigned long long* SELM = (unsigned long long*)(wsl + WS_SELM); gu32* ctl = (gu32*)(wsl + WS_CTL); gu32* cnt = ctl + CW_CNT; (void)cnt;
#define WCONV_CHUNK(ch_, wv_, ln_) do { const int ch = (ch_); LAS float* scr = (LAS float*)(L + (wv_) * 16384); \
        if (l == 0 && ch >= NCH_GU) { const int c3 = ch - NCH_GU, m = c3 / (NCH_F / 3), c4 = c3 - m * (NCH_F / 3); \
            if (m < 2) conv_four<true>(INP(22 + m), 0, 1024, 4096, WGU, 1024, 1, m * 128, 0, 0, 0, scr, c4 * CONV_CHUNK + (wv_), NWAVES, (ln_), m ? (float)(1 << (F8_WGU + F8_HID)) * 0.6931471805599453f : (float)(1 << F8_WGU) * 1.4426950408889634f);     \
            else conv_four<true>(INP(24), 0, 4096, 1024, WD, 4096, 0, 0, 0, 0, 0, scr, c4 * CONV_CHUNK + (wv_), NWAVES, (ln_), (float)(1 << F8_WD)); } \
        else if (l == 0) { const int up = ch >= NCH_GU / 2 ? 1 : 0, c2 = ch - up * (NCH_GU / 2); \
            conv_four<true>(INP(26 + up), (size_t)DM * DFE, 1024, DFE, MGU, 1024, 1, up * 128, 0, 2 * DFE, 0, scr, c2 * CONV_CHUNK + (wv_), NWAVES, (ln_), up ? (float)(1 << (F8_WGU + F8_HID)) * 0.6931471805599453f : (float)(1 << F8_WGU) * 1.4426950408889634f); }     \
        else conv_four<true>(INP(28), (size_t)DFE * DM, DFE, 1024, MD, DFE, 0, 0, 0, 1024, 0, scr, ch * CONV_CHUNK + (wv_), NWAVES, (ln_), (float)(1 << F8_WD)); } while (0)
#define KAS __attribute__((address_space(4)))
#define INP(i) ({ const KAS unsigned char* kp_ = (const KAS unsigned char*)__builtin_amdgcn_kernarg_segment_ptr(); asm volatile("" : "+s"(kp_)); (const float*)*(const GAS float* const KAS*)(kp_ + 8 * (i)); })
struct MkArgs { const float* in[29]; float* out; unsigned char* ws; int ph_lo, ph_hi; };
__global__ void __launch_bounds__(NWAVES * 64, 2) mk(MkArgs a) {
    extern __shared__ __attribute__((aligned(16))) unsigned char lds[];
    LAS unsigned char* L = (LAS unsigned char*)lds;
    const int G = gridDim.x, ngw = G * NWAVES, wave_s = __builtin_amdgcn_readfirstlane(threadIdx.x >> 6);
    unsigned char* ws = a.ws;
    for (int u = threadIdx.x; u < (LDS_BYTES - LDSCTL_OFF) / 4; u += NWAVES * 64) ((LAS unsigned*)(L + LDSCTL_OFF))[u] = 0u;
    __syncthreads();
    XcdBarrier bar = xcd_barrier_post((unsigned*)(ws + WS_CTL) + CW_BAR, (volatile LAS unsigned*)(L + MISC_OFF) + 8);
    const int lo = a.ph_lo, hi = a.ph_hi;
#define IN(k) (lo <= (k) && (k) < hi)
#define SEAM(k) do { if (IN(k) && IN((k) + 1)) { XcdBarrier b_ = bar; GAS unsigned* bp_ = (GAS unsigned*)bar.bar; asm volatile("" : "+s"(bp_)); b_.bar = (unsigned*)bp_; xcd_barrier(b_); } } while (0)
    float* xo = a.out;
    LAS int* tab = (LAS int*)(L + TAB_OFF);

    if (IN(PH_PRO)) { BUFS();
        LAS float* scr = (LAS float*)(L + wave * 16384);
        int rot = 0;
#define GWR(n_) ({ int g_ = gw - rot; if (g_ < 0) g_ += ngw; rot = (rot + (n_)) % ngw; g_; })
        for (int l = 0; l < 2; ++l) {
            conv_job(INP(2) + (size_t)l * 1024 * NIN, 1024, NIN, (bf16*)((unsigned char*)WIN + l * WIN_L), 1024, 0, 0, 0, scr, GWR(((1024) / 64) * (((NIN) + 31) / 32)), ngw, lane);
            conv_job(INP(5) + (size_t)l * 256 * 384, 256, 384, (bf16*)((unsigned char*)WUP + l * WUP_L), 384, 0, 0, 0, scr, GWR(((256) / 64) * (((384) + 31) / 32)), ngw, lane);
            conv_job(INP(7) + (size_t)l * 128 * 512, 128, 512, (bf16*)((unsigned char*)WUP + l * WUP_L), 384, 256, 0, 384, scr, GWR(((128) / 64) * (((512) + 31) / 32)), ngw, lane);
            conv_job_wo(INP(17) + (size_t)l * 1024 * 1024, (bf16*)((unsigned char*)WO + l * WO_L), INP(14) + l * 256, INP(15) + l * 256, INP(16) + l * 512, scr, GWR(16 * 32), ngw, lane);
        }
        for (int l = 0; l < 2; ++l) {
            zero_rect((bf16*)((unsigned char*)WIN + l * WIN_L), 1024, NIN, NINP - NIN, 0, 1024, GWR(NINP - NIN), ngw, lane);
            bf16* wu = (bf16*)((unsigned char*)WUP + l * WUP_L);
            zero_rect(wu, 384, 0, 384, 256, 128, GWR(384), ngw, lane); zero_rect(wu, 384, 384, 512, 0, 256, GWR(512), ngw, lane); zero_rect(wu, 384, 896, 128, 0, 384, GWR(128), ngw, lane);
            bf16* wc = (bf16*)((unsigned char*)WC1 + l * WC1_L);
            zero_rect(wc, 2048, 128, 128, 0, 2048, GWR(128), ngw, lane); zero_rect(wc, 2048, 384, 128, 0, 2048, GWR(128), ngw, lane); }
        for (int lw = 0; lw < 4; ++lw) conv_job(INP(lw & 1 ? 11 : 8) + (size_t)(lw >> 1) * 2048 * 128, 2048, 128, (bf16*)((unsigned char*)WC1 + (lw >> 1) * WC1_L), 2048, 0, 0, (lw & 1) * 256, scr, GWR(((2048) / 64) * (((128) + 31) / 32)), ngw, lane);
        for (int it = GWR(256); it < 256; it += ngw) {
            const int combo = it & 3, ch = it >> 2, ll = combo >> 1, which = combo & 1; const float* pe = INP(which ? 13 : 10) + (size_t)ll * 2048 + ch * 32; const float* w1 = INP(which ? 11 : 8) + (size_t)ll * 2048 * 128 + (size_t)ch * 32 * 128 + lane;
            float a0 = 0.f, a1 = 0.f;
#pragma unroll 8
            for (int kk = 0; kk < 32; ++kk) { const float p = pe[kk]; a0 += p * w1[kk * 128]; a1 += p * w1[kk * 128 + 64]; }
            CBPART[(size_t)it * 128 + lane] = a0; CBPART[(size_t)it * 128 + 64 + lane] = a1; }
        for (int idx = gw * 64 + lane; idx < NT * 16; idx += ngw * 64) { const int t = idx >> 4, i = idx & 15; const float ang = (float)((const int*)INP(1))[t] * rope_inv(i); ROPE[t * 32 + i] = cosf(ang); ROPE[t * 32 + 16 + i] = sinf(ang); }
        for (int row = gw; row < NT; row += 2 * ngw) { const int r1 = row + ngw < NT ? row + ngw : row; xn_row2(INP(0) + (size_t)row * DM, INP(0) + (size_t)r1 * DM, INP(18), XN + (size_t)row * DM, XN + (size_t)r1 * DM, lane); }
    #undef GWR
    }
    SEAM(PH_PRO);
    const unsigned uni = __builtin_amdgcn_readfirstlane(((volatile LAS unsigned*)(L + MISC_OFF))[8 + 2]);
    const int vb = uni ? (int)__builtin_amdgcn_readfirstlane(((volatile LAS unsigned*)(L + MISC_OFF))[8 + 3] * 8u + (xb_xcc_id() & 7u)) : (int)blockIdx.x;
#define SEAML(k) do { if (IN(k) && IN((k) + 1)) { XcdBarrier b_ = bar; GAS unsigned* bp_ = (GAS unsigned*)bar.bar; asm volatile("" : "+s"(bp_)); b_.bar = (unsigned*)bp_; if (uni) xcd_barrier_local(b_); else xcd_barrier(b_); } } while (0)
#define ROWMAP() const int rs_ = uni ? 2048 * (vb & 7) + (vb >> 3) * NWAVES + wave : gw, re_ = uni ? 2048 * ((vb & 7) + 1) : NT, rp_ = uni ? 256 : ngw

    { constexpr int l = 0;

    {
        const int pb = l == 0 ? L0_BASE : L1_BASE;

        if (IN(pb + J_INPROJ)) { BUFS(); pg8::Gemm g{XN, (const bf16*)((unsigned char*)WIN + l * WIN_L), NT, 2048, 1024}; pg8::StaticOrder S; S.init(NT, 2048, G, vb);
            pg8::EpiBf16s E{PROJ, NINP, NINP / 256, nullptr, nullptr}; pg8::gemm_phase<pg8::EpiBf16s, pg8::StaticOrder, true, true>(L, g, S, E, tid);
}
        SEAM(pb + J_INPROJ);
        if (IN(pb + J_PREP)) { BUFS();
            if (l == 0 && gw >= ngw - 64) { const int idx = (gw - (ngw - 64)) * 64 + lane, oi = idx >> 3, part = idx & 7, combo = oi >> 7, e = oi & 127;
                float a = 0.f;
#pragma unroll
                for (int j = 0; j < 8; ++j) a += CBPART[(size_t)((part * 8 + j) * 4 + combo) * 128 + e];
                a += shx(a, 1, lane); a += shx(a, 2, lane); a += shx(a, 4, lane);
                if (part == 0) CBIAS[oi] = a; }
            if (G >= 256) { if (blockIdx.x >= 128) for (int t = gw - 128 * NWAVES; t < NT; t += ngw - 128 * NWAVES)
                    mla_prep_row(PROJ + (size_t)t * NINP, ROPE + (size_t)t * 32, INP(4) + l * 256, INP(6) + l * 128, CQKV + (size_t)t * 384, KR + (size_t)t * 32, lane); }
            else for (int t = gw; t < NT; t += ngw) mla_prep_row(PROJ + (size_t)t * NINP, ROPE + (size_t)t * 32, INP(4) + l * 256, INP(6) + l * 128, CQKV + (size_t)t * 384, KR + (size_t)t * 32, lane);
            { pg8::Gemm g{XN, (const bf16*)((unsigned char*)WIN + l * WIN_L), NT, NINP, 1024}; TailColOrder S{G, (int)blockIdx.x};
              pg8::EpiBf16s E{PROJ, NINP, NINP / 256, nullptr, nullptr}; pg8::gemm_phase<pg8::EpiBf16s, TailColOrder, true, true>(L, g, S, E, tid); }
            __syncthreads();
            { pg8::Gemm g{PROJ, (const bf16*)((unsigned char*)WC1 + l * WC1_L), 0, 0, 512, 16 * NINP, 2048, NINP * 2, 1}; CompressOrder S{G, (int)blockIdx.x};
              pg8::EpiF32 E{HIDP, 128, 128}; pg8::gemm_phase<pg8::EpiF32, CompressOrder, true, true>(L, g, S, E, tid); }
        }
        SEAM(pb + J_PREP);
        if (IN(pb + J_MLAUP)) { BUFS(); pg8::Gemm g{CQKV, (const bf16*)((unsigned char*)WUP + l * WUP_L), NT, 1024, 384}; pg8::StaticOrder S; S.init(NT, 1024, G, (int)blockIdx.x);
            pg8::EpiMlaUp E{QB, KVB}; pg8::gemm_phase<pg8::EpiMlaUp, pg8::StaticOrder, true, true>(L, g, S, E, tid);
            LAS float* hb = (LAS float*)(L + wave * 1024);
            for (int it = gw; it < NB * NCMP * 4; it += ngw) { const int which = it & 1, g2 = (it >> 1) & 1, bn = it >> 2, n = bn % NCMP, b = bn / NCMP;
                compress_finish_item(HIDP, CBIAS + (l * 2 + which) * 128, INP(which ? 12 : 9) + (size_t)l * 128 * 64, which ? VCB : KCB, b, g2, which, n, hb, lane); }
            if (gw < 16) { bf16* z = (gw & 1 ? VCB : KCB) + ((size_t)(gw >> 1) * 256 + 255) * 64; z[lane] = 0; }
        }
        SEAM(pb + J_MLAUP);
        if (IN(pb + J_ATTN)) { BUFS();
            const int xq = (int)(xb_xcc_id() & 7u);
            gu32* qb = ctl + CW_QX + 64 * ((pb + J_ATTN) * 8 + xq); LAS int* slot = (LAS int*)(L + RING_BYTES + 512);
            int nxt = 0; if (threadIdx.x == 0) nxt = (int)__hip_atomic_fetch_add(qb, 1u, RLX_AGENT);
            for (;;) { int tq_; asm volatile("v_mbcnt_lo_u32_b32 %0, -1, 0\n\tv_mbcnt_hi_u32_b32 %0, -1, %0" : "=v"(tq_)); tq_ += wave_s * 64;
                if (tq_ == 0) *slot = nxt;
                __syncthreads();
                const int nprep = 0, NCX = ((l == 0 ? NCH_GU + NCH_F : NCH_D) - nprep) / 8, QT = 192 + NCX;
                int it = *slot; if (it >= 32 + QT) break;
                if (tq_ == 0) nxt = (int)__hip_atomic_fetch_add(qb, 1u, RLX_AGENT);
                int cchunk = -1; if (it >= 32) { const int p = it - 32, nc = p * NCX / QT; if ((p + 1) * NCX / QT > nc) cchunk = nc; else it = 32 + p - nc; }
                if (cchunk >= 0) {
                    WCONV_CHUNK(nprep + cchunk * 8 + xq, wave_s, tq_ & 63);
                    continue; }
                if (it < 32) { const int bh = 2 * xq + (it >> 4), s = it & 15; attn_b_unit(L, QB, KVB, KR, ROPE, MIXED, SSQ0, bh >> 2, bh & 3, 31 - s, tq_); asm volatile("" : "+v"(tq_)); attn_b_unit(L, QB, KVB, KR, ROPE, MIXED, SSQ0, bh >> 2, bh & 3, s, tq_); }
                else if (it < 160) { attn_c_unit(L, PROJ, KCB, VCB, MIXED, SSQ0, xq >> 1, xq & 1, 127 - (it - 32), tq_); }
                else { attn_a_unit(L, PROJ, INP(3) + l * 4, MIXED, SSQ0, xq >> 1, xq & 1, it - 160, tq_); } }
        }
        SEAM(pb + J_ATTN);
        if (IN(pb + J_WO)) { BUFS(); pg8::StaticOrder S; S.init(NT, 1024, G, vb); LAS float* rt = (LAS float*)(L + RING_BYTES + 4096);
            for (int i = 0; ; ++i) { pg8::Unit u; if (!S.next(i, u)) break;
                __syncthreads();
                if (tid < 256) { const f32x4* qp = (const f32x4*)(SSQ0 + (size_t)(u.pm * 256 + tid) * 16); const f32x4 qa = qp[0], qb = qp[1], qc = qp[2], qd = qp[3];
                    const float sa = (qa[0] + qa[1]) + (qa[2] + qa[3]), sb = (qb[0] + qb[1]) + (qb[2] + qb[3]), sc = ((qc[0] + qc[1]) + (qc[2] + qc[3])) + ((qd[0] + qd[1]) + (qd[2] + qd[3]));
                    const float ra = 1.0f / sqrtf(sa * (1.0f / 256) + EPS), rb = 1.0f / sqrtf(sb * (1.0f / 256) + EPS), rc = 1.0f / sqrtf(sc * (1.0f / 512) + EPS);
                    rt[4 * tid] = ra / rb; rt[4 * tid + 1] = rb / rc; rt[4 * tid + 2] = rc; }
                __syncthreads();
                pg8::Gemm g{MIXED, (const bf16*)((unsigned char*)WO + l * WO_L), NT, 1024, 1024}; OneUnit S1{u};
                pg8::EpiWo E{MOUT, DM, rt}; pg8::gemm_phase<pg8::EpiWo, OneUnit, true, true>(L, g, S1, E, tid); } }
        SEAML(pb + J_WO);
        if (IN(pb + J_RESN)) { BUFS();
            const float* xsrc = l == 0 ? INP(0) : (const float*)xo; ROWMAP();
            for (int t0 = rs_; t0 < re_; t0 += 2 * rp_) { const int t1 = t0 + rp_ < re_ ? t0 + rp_ : t0; f32x4 m0[4], m1[4], x0[4], x1[4];
#pragma unroll
                for (int j = 0; j < 4; ++j) { const uint2 w0 = ((const uint2*)(MOUT + (size_t)t0 * DM))[lane + 64 * j], w1 = ((const uint2*)(MOUT + (size_t)t1 * DM))[lane + 64 * j];
                    m0[j] = (f32x4){bflo(w0.x), bfhi(w0.x), bflo(w0.y), bfhi(w0.y)}; m1[j] = (f32x4){bflo(w1.x), bfhi(w1.x), bflo(w1.y), bfhi(w1.y)};
                    x0[j] = ((const f32x4*)(xsrc + (size_t)t0 * DM))[lane + 64 * j]; x1[j] = ((const f32x4*)(xsrc + (size_t)t1 * DM))[lane + 64 * j]; }
                resnorm_row(m0, x0, INP(19) + l * DM, l == 0 ? nullptr : xo + (size_t)t0 * DM, INP(20) + l * DM, XN + (size_t)t0 * DM, l == 1 ? INP(25) : nullptr, t0, TOKE, TOKP, TOKW, cnt, lane, l == 1 ? (unsigned char*)AG : nullptr, ROWWE, l == 0 ? (unsigned char*)XN + (size_t)t0 * DM : nullptr);
                if (t1 != t0) resnorm_row(m1, x1, INP(19) + l * DM, l == 0 ? nullptr : xo + (size_t)t1 * DM, INP(20) + l * DM, XN + (size_t)t1 * DM, l == 1 ? INP(25) : nullptr, t1, TOKE, TOKP, TOKW, cnt, lane, l == 1 ? (unsigned char*)AG : nullptr, ROWWE, l == 0 ? (unsigned char*)XN + (size_t)t1 * DM : nullptr); }
        }
        if (l == 0) SEAML(pb + J_RESN); else SEAM(pb + J_RESN);
        if (l == 0) {
            if (IN(pb + J_F1)) { BUFS(); pg8::Gemm g{XN, WGU, NT, 2 * DFF, 1024 / 2}; pg8::StaticOrder S; S.init(NT, 2 * DFF, G, vb);
                pg8::EpiSwiGLU8 E{(unsigned char*)HIDB, DFF, DFF / 128}; pg8::gemm_phase<pg8::EpiSwiGLU8, pg8::StaticOrder, true, true, F8S_GU>(L, g, S, E, tid); }
            SEAML(pb + J_F1);
            if (IN(pb + J_F2)) { BUFS(); pg8::Gemm g{HIDB, WD, NT, 1024, DFF / 2}; pg8::StaticOrder S; S.init(NT, 1024, G, vb);
                pg8::EpiBf16s E{FOUT, DM, 4, nullptr, nullptr}; pg8::gemm_phase<pg8::EpiBf16s, pg8::StaticOrder, true, true, F8S_D>(L, g, S, E, tid); }
            SEAML(pb + J_F2);
            if (IN(pb + J_F3)) { BUFS(); ROWMAP();
                for (int t0 = rs_; t0 < re_; t0 += 2 * rp_) { const int t1 = t0 + rp_ < re_ ? t0 + rp_ : t0; f32x4 m0[4], m1[4], x0[4], x1[4]; uint2 p0[4], p1[4];
#pragma unroll
                    for (int j = 0; j < 4; ++j) { const uint2 w0 = ((const uint2*)(FOUT + (size_t)t0 * DM))[lane + 64 * j], w1 = ((const uint2*)(FOUT + (size_t)t1 * DM))[lane + 64 * j];
                        m0[j] = (f32x4){bflo(w0.x), bfhi(w0.x), bflo(w0.y), bfhi(w0.y)}; m1[j] = (f32x4){bflo(w1.x), bfhi(w1.x), bflo(w1.y), bfhi(w1.y)};
                        x0[j] = ((const f32x4*)(INP(0) + (size_t)t0 * DM))[lane + 64 * j]; x1[j] = ((const f32x4*)(INP(0) + (size_t)t1 * DM))[lane + 64 * j];
                        p0[j] = ((const uint2*)(MOUT + (size_t)t0 * DM))[lane + 64 * j]; p1[j] = ((const uint2*)(MOUT + (size_t)t1 * DM))[lane + 64 * j]; }
                    add_post(x0, p0, INP(19), lane); add_post(x1, p1, INP(19), lane);
                    resnorm_row(m0, x0, INP(21), xo + (size_t)t0 * DM, INP(18) + DM, XN + (size_t)t0 * DM, nullptr, t0, TOKE, TOKP, TOKW, cnt, lane);
                    if (t1 != t0) resnorm_row(m1, x1, INP(21), xo + (size_t)t1 * DM, INP(18) + DM, XN + (size_t)t1 * DM, nullptr, t1, TOKE, TOKP, TOKW, cnt, lane); }
            }
            SEAML(pb + J_F3);
        } else {
            if (IN(pb + J_F1)) { BUFS(); moe_table(cnt, tab, tid);
                pg8::Gemm g{AG, MGU, MOE_ROWS, NEXP * 2 * DFE, 1024 / 2, 0, 0, 0, 1}; MoeOrder S{2 * DFE / 256, G, (int)blockIdx.x, tab, 0, 1};
                pg8::EpiSwiGLU8 E{(unsigned char*)HIDM, DFE, 2 * DFE / 256}; pg8::gemm_phase<pg8::EpiSwiGLU8, MoeOrder, true, true, F8S_GU>(L, g, S, E, tid); }
            SEAM(pb + J_F1);
            if (IN(pb + J_F2)) { BUFS(); moe_table(cnt, tab, tid);
                { pg8::Gemm g{HIDM, MD, MOE_ROWS, NEXP * 1024, DFE / 2}; MoeOrder S{4, G, (int)blockIdx.x, tab, 128};
                  pg8::EpiF8s E{(unsigned char*)PAIR, 4, ROWWE, tab, (float)(1 << F8_PAIR)}; pg8::gemm_phase<pg8::EpiF8s, MoeOrder, true, true, F8S_D>(L, g, S, E, tid); }
                __syncthreads();
                { pg8::Gemm g{HIDM, MD, MOE_ROWS, NEXP * 1024, 512 / 2, DFE / 2, DFE / 2, 0, 1}; MoeTailOrder S{G, (int)blockIdx.x, tab};
                  pg8::EpiPart E{PART, ROWWE, tab}; pg8::gemm_phase<pg8::EpiPart, MoeTailOrder, true, true, F8S_D>(L, g, S, E, tid); } }
            SEAM(pb + J_F2);
            if (IN(pb + J_F3)) { BUFS(); moe_table(cnt, tab, tid);
                for (int t0 = gw; t0 < NT; t0 += 2 * ngw) { const int t1 = t0 + ngw < NT ? t0 + ngw : t0;
                    const int r00 = tab[TOKE[2 * t0]] + TOKP[2 * t0], r01 = tab[TOKE[2 * t0 + 1]] + TOKP[2 * t0 + 1], r10 = tab[TOKE[2 * t1]] + TOKP[2 * t1], r11 = tab[TOKE[2 * t1 + 1]] + TOKP[2 * t1 + 1];
                    f32x4 m0[4], m1[4], x0[4], x1[4];
#pragma unroll
                    for (int j = 0; j < 4; ++j) { m0[j] = pair_vals(PAIR, PART, r00, lane + 64 * j) + pair_vals(PAIR, PART, r01, lane + 64 * j); m1[j] = pair_vals(PAIR, PART, r10, lane + 64 * j) + pair_vals(PAIR, PART, r11, lane + 64 * j);
                        x0[j] = ((const f32x4*)(xo + (size_t)t0 * DM))[lane + 64 * j]; x1[j] = ((const f32x4*)(xo + (size_t)t1 * DM))[lane + 64 * j]; }
                    resnorm_row(m0, x0, INP(21) + DM, xo + (size_t)t0 * DM, nullptr, nullptr, nullptr, t0, TOKE, TOKP, TOKW, cnt, lane);
                    if (t1 != t0) resnorm_row(m1, x1, INP(21) + DM, xo + (size_t)t1 * DM, nullptr, nullptr, nullptr, t1, TOKE, TOKP, TOKW, cnt, lane); }
            }
        }
    }
        }
    { constexpr int l = 1;

    {
        const int pb = l == 0 ? L0_BASE : L1_BASE;

        if (IN(pb + J_INPROJ)) { BUFS(); pg8::Gemm g{XN, (const bf16*)((unsigned char*)WIN + l * WIN_L), NT, 2048, 1024}; pg8::StaticOrder S; S.init(NT, 2048, G, vb);
            pg8::EpiBf16s E{PROJ, NINP, NINP / 256, nullptr, nullptr}; pg8::gemm_phase<pg8::EpiBf16s, pg8::StaticOrder, true, true>(L, g, S, E, tid);
}
        SEAM(pb + J_INPROJ);
        if (IN(pb + J_PREP)) { BUFS();
            if (l == 0 && gw >= ngw - 64) { const int idx = (gw - (ngw - 64)) * 64 + lane, oi = idx >> 3, part = idx & 7, combo = oi >> 7, e = oi & 127;
                float a = 0.f;
#pragma unroll
                for (int j = 0; j < 8; ++j) a += CBPART[(size_t)((part * 8 + j) * 4 + combo) * 128 + e];
                a += shx(a, 1, lane); a += shx(a, 2, lane); a += shx(a, 4, lane);
                if (part == 0) CBIAS[oi] = a; }
            if (G >= 256) { if (blockIdx.x >= 128) for (int t = gw - 128 * NWAVES; t < NT; t += ngw - 128 * NWAVES)
                    mla_prep_row(PROJ + (size_t)t * NINP, ROPE + (size_t)t * 32, INP(4) + l * 256, INP(6) + l * 128, CQKV + (size_t)t * 384, KR + (size_t)t * 32, lane); }
            else for (int t = gw; t < NT; t += ngw) mla_prep_row(PROJ + (size_t)t * NINP, ROPE + (size_t)t * 32, INP(4) + l * 256, INP(6) + l * 128, CQKV + (size_t)t * 384, KR + (size_t)t * 32, lane);
            { pg8::Gemm g{XN, (const bf16*)((unsigned char*)WIN + l * WIN_L), NT, NINP, 1024}; TailColOrder S{G, (int)blockIdx.x};
              pg8::EpiBf16s E{PROJ, NINP, NINP / 256, nullptr, nullptr}; pg8::gemm_phase<pg8::EpiBf16s, TailColOrder, true, true>(L, g, S, E, tid); }
            __syncthreads();
            { pg8::Gemm g{PROJ, (const bf16*)((unsigned char*)WC1 + l * WC1_L), 0, 0, 512, 16 * NINP, 2048, NINP * 2, 1}; CompressOrder S{G, (int)blockIdx.x};
              pg8::EpiF32 E{HIDP, 128, 128}; pg8::gemm_phase<pg8::EpiF32, CompressOrder, true, true>(L, g, S, E, tid); }
        }
        SEAM(pb + J_PREP);
        if (IN(pb + J_MLAUP)) { BUFS(); pg8::Gemm g{CQKV, (const bf16*)((unsigned char*)WUP + l * WUP_L), NT, 1024, 384}; pg8::StaticOrder S; S.init(NT, 1024, G, (int)blockIdx.x);
            pg8::EpiMlaUp E{QB, KVB}; pg8::gemm_phase<pg8::EpiMlaUp, pg8::StaticOrder, true, true>(L, g, S, E, tid);
            LAS float* hb = (LAS float*)(L + wave * 1024);
            for (int it = gw; it < NB * NCMP * 4; it += ngw) { const int which = it & 1, g2 = (it >> 1) & 1, bn = it >> 2, n = bn % NCMP, b = bn / NCMP;
                compress_finish_item(HIDP, CBIAS + (l * 2 + which) * 128, INP(which ? 12 : 9) + (size_t)l * 128 * 64, which ? VCB : KCB, b, g2, which, n, hb, lane); }
            if (gw < 16) { bf16* z = (gw & 1 ? VCB : KCB) + ((size_t)(gw >> 1) * 256 + 255) * 64; z[lane] = 0; }
        }
        SEAM(pb + J_MLAUP);
        if (IN(pb + J_ATTN)) { BUFS();
            const int xq = (int)(xb_xcc_id() & 7u);
            gu32* qb = ctl + CW_QX + 64 * ((pb + J_ATTN) * 8 + xq); LAS int* slot = (LAS int*)(L + RING_BYTES + 512);
            int nxt = 0; if (threadIdx.x == 0) nxt = (int)__hip_atomic_fetch_add(qb, 1u, RLX_AGENT);
            for (;;) { int tq_; asm volatile("v_mbcnt_lo_u32_b32 %0, -1, 0\n\tv_mbcnt_hi_u32_b32 %0, -1, %0" : "=v"(tq_)); tq_ += wave_s * 64;
                if (tq_ == 0) *slot = nxt;
                __syncthreads();
                const int nprep = 0, NCX = ((l == 0 ? NCH_GU + NCH_F : NCH_D) - nprep) / 8, QT = 192 + NCX;
                int it = *slot; if (it >= 32 + QT) break;
                if (tq_ == 0) nxt = (int)__hip_atomic_fetch_add(qb, 1u, RLX_AGENT);
                int cchunk = -1; if (it >= 32) { const int p = it - 32, nc = p * NCX / QT; if ((p + 1) * NCX / QT > nc) cchunk = nc; else it = 32 + p - nc; }
                if (cchunk >= 0) {
                    WCONV_CHUNK(nprep + cchunk * 8 + xq, wave_s, tq_ & 63);
                    continue; }
                if (it < 32) { const int bh = 2 * xq + (it >> 4), s = it & 15; attn_b_unit(L, QB, KVB, KR, ROPE, MIXED, SSQ0, bh >> 2, bh & 3, 31 - s, tq_); asm volatile("" : "+v"(tq_)); attn_b_unit(L, QB, KVB, KR, ROPE, MIXED, SSQ0, bh >> 2, bh & 3, s, tq_); }
                else if (it < 160) { attn_c_unit(L, PROJ, KCB, VCB, MIXED, SSQ0, xq >> 1, xq & 1, 127 - (it - 32), tq_); }
                else { attn_a_unit(L, PROJ, INP(3) + l * 4, MIXED, SSQ0, xq >> 1, xq & 1, it - 160, tq_); } }
        }
        SEAM(pb + J_ATTN);
        if (IN(pb + J_WO)) { BUFS(); pg8::StaticOrder S; S.init(NT, 1024, G, vb); LAS float* rt = (LAS float*)(L + RING_BYTES + 4096);
            for (int i = 0; ; ++i) { pg8::Unit u; if (!S.next(i, u)) break;
                __syncthreads();
                if (tid < 256) { const f32x4* qp = (const f32x4*)(SSQ0 + (size_t)(u.pm * 256 + tid) * 16); const f32x4 qa = qp[0], qb = qp[1], qc = qp[2], qd = qp[3];
                    const float sa = (qa[0] + qa[1]) + (qa[2] + qa[3]), sb = (qb[0] + qb[1]) + (qb[2] + qb[3]), sc = ((qc[0] + qc[1]) + (qc[2] + qc[3])) + ((qd[0] + qd[1]) + (qd[2] + qd[3]));
                    const float ra = 1.0f / sqrtf(sa * (1.0f / 256) + EPS), rb = 1.0f / sqrtf(sb * (1.0f / 256) + EPS), rc = 1.0f / sqrtf(sc * (1.0f / 512) + EPS);
                    rt[4 * tid] = ra / rb; rt[4 * tid + 1] = rb / rc; rt[4 * tid + 2] = rc; }
                __syncthreads();
                pg8::Gemm g{MIXED, (const bf16*)((unsigned char*)WO + l * WO_L), NT, 1024, 1024}; OneUnit S1{u};
                pg8::EpiWo E{MOUT, DM, rt}; pg8::gemm_phase<pg8::EpiWo, OneUnit, true, true>(L, g, S1, E, tid); } }
        SEAML(pb + J_WO);
        if (IN(pb + J_RESN)) { BUFS();
            const float* xsrc = l == 0 ? INP(0) : (const float*)xo; ROWMAP();
            for (int t0 = rs_; t0 < re_; t0 += 2 * rp_) { const int t1 = t0 + rp_ < re_ ? t0 + rp_ : t0; f32x4 m0[4], m1[4], x0[4], x1[4];
#pragma unroll
                for (int j = 0; j < 4; ++j) { const uint2 w0 = ((const uint2*)(MOUT + (size_t)t0 * DM))[lane + 64 * j], w1 = ((const uint2*)(MOUT + (size_t)t1 * DM))[lane + 64 * j];
                    m0[j] = (f32x4){bflo(w0.x), bfhi(w0.x), bflo(w0.y), bfhi(w0.y)}; m1[j] = (f32x4){bflo(w1.x), bfhi(w1.x), bflo(w1.y), bfhi(w1.y)};
                    x0[j] = ((const f32x4*)(xsrc + (size_t)t0 * DM))[lane + 64 * j]; x1[j] = ((const f32x4*)(xsrc + (size_t)t1 * DM))[lane + 64 * j]; }
                resnorm_row(m0, x0, INP(19) + l * DM, l == 0 ? nullptr : xo + (size_t)t0 * DM, INP(20) + l * DM, XN + (size_t)t0 * DM, l == 1 ? INP(25) : nullptr, t0, TOKE, TOKP, TOKW, cnt, lane, l == 1 ? (unsigned char*)AG : nullptr, ROWWE, l == 0 ? (unsigned char*)XN + (size_t)t0 * DM : nullptr);
                if (t1 != t0) resnorm_row(m1, x1, INP(19) + l * DM, l == 0 ? nullptr : xo + (size_t)t1 * DM, INP(20) + l * DM, XN + (size_t)t1 * DM, l == 1 ? INP(25) : nullptr, t1, TOKE, TOKP, TOKW, cnt, lane, l == 1 ? (unsigned char*)AG : nullptr, ROWWE, l == 0 ? (unsigned char*)XN + (size_t)t1 * DM : nullptr); }
        }
        if (l == 0) SEAML(pb + J_RESN); else SEAM(pb + J_RESN);
        if (l == 0) {
            if (IN(pb + J_F1)) { BUFS(); pg8::Gemm g{XN, WGU, NT, 2 * DFF, 1024 / 2}; pg8::StaticOrder S; S.init(NT, 2 * DFF, G, vb);
                pg8::EpiSwiGLU8 E{(unsigned char*)HIDB, DFF, DFF / 128}; pg8::gemm_phase<pg8::EpiSwiGLU8, pg8::StaticOrder, true, true, F8S_GU>(L, g, S, E, tid); }
            SEAML(pb + J_F1);
            if (IN(pb + J_F2)) { BUFS(); pg8::Gemm g{HIDB, WD, NT, 1024, DFF / 2}; pg8::StaticOrder S; S.init(NT, 1024, G, vb);
                pg8::EpiBf16s E{FOUT, DM, 4, nullptr, nullptr}; pg8::gemm_phase<pg8::EpiBf16s, pg8::StaticOrder, true, true, F8S_D>(L, g, S, E, tid); }
            SEAML(pb + J_F2);
            if (IN(pb + J_F3)) { BUFS(); ROWMAP();
                for (int t0 = rs_; t0 < re_; t0 += 2 * rp_) { const int t1 = t0 + rp_ < re_ ? t0 + rp_ : t0; f32x4 m0[4], m1[4], x0[4], x1[4]; uint2 p0[4], p1[4];
#pragma unroll
                    for (int j = 0; j < 4; ++j) { const uint2 w0 = ((const uint2*)(FOUT + (size_t)t0 * DM))[lane + 64 * j], w1 = ((const uint2*)(FOUT + (size_t)t1 * DM))[lane + 64 * j];
                        m0[j] = (f32x4){bflo(w0.x), bfhi(w0.x), bflo(w0.y), bfhi(w0.y)}; m1[j] = (f32x4){bflo(w1.x), bfhi(w1.x), bflo(w1.y), bfhi(w1.y)};
                        x0[j] = ((const f32x4*)(INP(0) + (size_t)t0 * DM))[lane + 64 * j]; x1[j] = ((const f32x4*)(INP(0) + (size_t)t1 * DM))[lane + 64 * j];
                        p0[j] = ((const uint2*)(MOUT + (size_t)t0 * DM))[lane + 64 * j]; p1[j] = ((const uint2*)(MOUT + (size_t)t1 * DM))[lane + 64 * j]; }
                    add_post(x0, p0, INP(19), lane); add_post(x1, p1, INP(19), lane);
                    resnorm_row(m0, x0, INP(21), xo + (size_t)t0 * DM, INP(18) + DM, XN + (size_t)t0 * DM, nullptr, t0, TOKE, TOKP, TOKW, cnt, lane);
                    if (t1 != t0) resnorm_row(m1, x1, INP(21), xo + (size_t)t1 * DM, INP(18) + DM, XN + (size_t)t1 * DM, nullptr, t1, TOKE, TOKP, TOKW, cnt, lane); }
            }
            SEAML(pb + J_F3);
        } else {
            if (IN(pb + J_F1)) { BUFS(); moe_table(cnt, tab, tid);
                pg8::Gemm g{AG, MGU, MOE_ROWS, NEXP * 2 * DFE, 1024 / 2, 0, 0, 0, 1}; MoeOrder S{2 * DFE / 256, G, (int)blockIdx.x, tab, 0, 1};
                pg8::EpiSwiGLU8 E{(unsigned char*)HIDM, DFE, 2 * DFE / 256}; pg8::gemm_phase<pg8::EpiSwiGLU8, MoeOrder, true, true, F8S_GU>(L, g, S, E, tid); }
            SEAM(pb + J_F1);
            if (IN(pb + J_F2)) { BUFS(); moe_table(cnt, tab, tid);
                { pg8::Gemm g{HIDM, MD, MOE_ROWS, NEXP * 1024, DFE / 2}; MoeOrder S{4, G, (int)blockIdx.x, tab, 128};
                  pg8::EpiF8s E{(unsigned char*)PAIR, 4, ROWWE, tab, (float)(1 << F8_PAIR)}; pg8::gemm_phase<pg8::EpiF8s, MoeOrder, true, true, F8S_D>(L, g, S, E, tid); }
                __syncthreads();
                { pg8::Gemm g{HIDM, MD, MOE_ROWS, NEXP * 1024, 512 / 2, DFE / 2, DFE / 2, 0, 1}; MoeTailOrder S{G, (int)blockIdx.x, tab};
                  pg8::EpiPart E{PART, ROWWE, tab}; pg8::gemm_phase<pg8::EpiPart, MoeTailOrder, true, true, F8S_D>(L, g, S, E, tid); } }
            SEAM(pb + J_F2);
            if (IN(pb + J_F3)) { BUFS(); moe_table(cnt, tab, tid);
                for (int t0 = gw; t0 < NT; t0 += 2 * ngw) { const int t1 = t0 + ngw < NT ? t0 + ngw : t0;
                    const int r00 = tab[TOKE[2 * t0]] + TOKP[2 * t0], r01 = tab[TOKE[2 * t0 + 1]] + TOKP[2 * t0 + 1], r10 = tab[TOKE[2 * t1]] + TOKP[2 * t1], r11 = tab[TOKE[2 * t1 + 1]] + TOKP[2 * t1 + 1];
                    f32x4 m0[4], m1[4], x0[4], x1[4];
#pragma unroll
                    for (int j = 0; j < 4; ++j) { m0[j] = pair_vals(PAIR, PART, r00, lane + 64 * j) + pair_vals(PAIR, PART, r01, lane + 64 * j); m1[j] = pair_vals(PAIR, PART, r10, lane + 64 * j) + pair_vals(PAIR, PART, r11, lane + 64 * j);
                        x0[j] = ((const f32x4*)(xo + (size_t)t0 * DM))[lane + 64 * j]; x1[j] = ((const f32x4*)(xo + (size_t)t1 * DM))[lane + 64 * j]; }
                    resnorm_row(m0, x0, INP(21) + DM, xo + (size_t)t0 * DM, nullptr, nullptr, nullptr, t0, TOKE, TOKP, TOKW, cnt, lane);
                    if (t1 != t0) resnorm_row(m1, x1, INP(21) + DM, xo + (size_t)t1 * DM, nullptr, nullptr, nullptr, t1, TOKE, TOKP, TOKW, cnt, lane); }
            }
        }
    }
        }

#undef IN
#undef SEAM
#undef SEAML
#undef ROWMAP
}

#ifndef MK_PER_PHASE
#define MK_PER_PHASE 0
#endif
extern "C" void kernel_launch(void* const* d_in, const int* in_sizes, int n_in, void* d_out, int out_size, void* d_ws, size_t ws_size, hipStream_t stream) {
    if (ws_size < WS_END || n_in != 29) return;
    static int grid = 0;
    if (!grid) { int dev = 0, cus = 0; (void)hipGetDevice(&dev); (void)hipDeviceGetAttribute(&cus, hipDeviceAttributeMultiprocessorCount, dev);
        (void)hipFuncSetAttribute((const void*)mk, hipFuncAttributeMaxDynamicSharedMemorySize, LDS_BYTES); (void)hipGetLastError(); grid = cus > 0 ? cus : 256; }
    unsigned char* ws = (unsigned char*)d_ws;
    (void)hipMemsetAsync(ws + WS_CTL, 0, CTL_ZERO_BYTES, stream);
    MkArgs a{}; for (int i = 0; i < 29; ++i) a.in[i] = (const float*)d_in[i]; a.out = (float*)d_out; a.ws = ws;
#if MK_PER_PHASE
    for (int p = 0; p < NPH; ++p) { a.ph_lo = p; a.ph_hi = p + 1; hipLaunchKernelGGL(mk, dim3(grid), dim3(NWAVES * 64), LDS_BYTES, stream, a); }
#else
    a.ph_lo = 0; a.ph_hi = NPH; hipLaunchKernelGGL(mk, dim3(grid), dim3(NWAVES * 64), LDS_BYTES, stream, a);
#endif
}
```
